# Optimizing an MI355X kernel written in HIP

```python
import math
import jax, jax.numpy as jnp
from jax import lax
import numpy as np

D_MODEL = 1024
BATCH = 2
SEQ = 16384
DEPTH = 2

HEAD_DIM = 64
GDN_HEADS = 6
GDN_CONV = 4
GDN_CHUNK = 64
GDN_WIDTH = GDN_HEADS * HEAD_DIM
NSA_HEADS = 6
NSA_KV_HEADS = 2
NSA_GROUP = NSA_HEADS // NSA_KV_HEADS
NSA_WIDTH = NSA_HEADS * HEAD_DIM
NSA_KV_WIDTH = NSA_KV_HEADS * HEAD_DIM
CMP_LEN = 32
CMP_STRIDE = 16
CMP_HIDDEN = 256
SEL_BLOCK = 64
SEL_TOPK = 16
WINDOW = 512
Q_BLOCK = 128
FORCED_SCORE = 1e4
POOL_WINDOWS = (2, 4, 8, 16)
POOL_GROUP_DIM = 64
POOL_WIDTH = 4 * POOL_GROUP_DIM
D_MIX = GDN_WIDTH + NSA_WIDTH + POOL_WIDTH
IN_SPLITS = (3 * GDN_WIDTH, GDN_WIDTH, GDN_HEADS, GDN_HEADS, NSA_WIDTH, 6 * NSA_KV_WIDTH, 3 * NSA_HEADS, POOL_WIDTH)
D_IN = 3 * GDN_WIDTH + GDN_WIDTH + GDN_HEADS + GDN_HEADS + NSA_WIDTH + 6 * NSA_KV_WIDTH + 3 * NSA_HEADS + POOL_WIDTH
D_FF = 4 * D_MODEL
EPS = 1e-6

kernel_name = "hymba_gdn_nsa_pool_hybrid"


def rms_norm(x, g):
    xf = x.astype(jnp.float32)
    return (xf * lax.rsqrt(jnp.mean(xf * xf, axis=-1, keepdims=True) + EPS) * g).astype(x.dtype)


def l2norm(x):
    xf = x.astype(jnp.float32)
    return xf * lax.rsqrt(jnp.sum(xf * xf, axis=-1, keepdims=True) + EPS)


def masked_softmax(s, mask):
    s = jnp.where(mask, s.astype(jnp.float32), -1e30)
    return jax.nn.softmax(s, axis=-1) * mask


def split_columns(proj):
    offs = []
    acc = 0
    for s in IN_SPLITS[:-1]:
        acc += s
        offs.append(acc)
    return jnp.split(proj, offs, axis=-1)


def causal_conv(x, w):
    T = x.shape[1]
    K = w.shape[0]
    xp = jnp.pad(x, ((0, 0), (K - 1, 0), (0, 0)))
    return sum(xp[:, k:k + T] * w[k] for k in range(K))


def gated_delta_rule(q, k, v, beta, g):
    B, T, H, Dk = q.shape
    Dv = v.shape[-1]
    C = GDN_CHUNK
    N = T // C
    f32 = jnp.float32

    def chunks(a):
        a = a.astype(f32).reshape((B, N, C, H) + a.shape[3:])
        return jnp.moveaxis(a, 3, 1)

    q, k, v, beta, g = map(chunks, (q, k, v, beta, g))
    q = q * Dk ** -0.5
    gc = jnp.cumsum(g, axis=-1)
    causal = jnp.tril(jnp.ones((C, C), bool))
    strict = jnp.tril(jnp.ones((C, C), bool), -1)
    decay = jnp.exp(jnp.where(causal, gc[..., :, None] - gc[..., None, :], -jnp.inf))
    k_beta = k * beta[..., None]
    L = jnp.where(strict, jnp.einsum('bhncd,bhnsd->bhncs', k_beta, k) * decay, 0.0)
    A = jnp.eye(C, dtype=f32) + L
    u = lax.linalg.triangular_solve(A, v * beta[..., None], left_side=True, lower=True, unit_diagonal=True)
    w = lax.linalg.triangular_solve(A, k_beta * jnp.exp(gc)[..., None], left_side=True, lower=True, unit_diagonal=True)
    qk = jnp.einsum('bhncd,bhnsd->bhncs', q, k) * decay
    q_dec = q * jnp.exp(gc)[..., None]
    k_dec = k * jnp.exp(gc[..., -1:] - gc)[..., None]
    g_last = jnp.exp(gc[..., -1])

    def step(S, xs):
        u_i, w_i, qk_i, qd_i, kd_i, gl_i = xs
        v_new = u_i - jnp.einsum('bhcd,bhde->bhce', w_i, S)
        o = jnp.einsum('bhcd,bhde->bhce', qd_i, S) + jnp.einsum('bhcs,bhse->bhce', qk_i, v_new)
        S = S * gl_i[..., None, None] + jnp.einsum('bhcd,bhce->bhde', kd_i, v_new)
        return S, o

    xs = tuple(jnp.moveaxis(a, 2, 0) for a in (u, w, qk, q_dec, k_dec, g_last))
    S0 = jnp.zeros((B, H, Dk, Dv), f32)
    _, o = lax.scan(step, S0, xs)
    return jnp.transpose(o, (1, 0, 3, 2, 4)).reshape(B, T, H, Dv)


def gdn_mixer(qkv, z, b, a, conv_w, a_log, dt_bias, norm_g):
    B, T, _ = qkv.shape
    qkv = jax.nn.silu(causal_conv(qkv, conv_w))
    q, k, v = jnp.split(qkv, 3, axis=-1)
    heads = lambda t: t.reshape(B, T, GDN_HEADS, HEAD_DIM)
    q, k, v = l2norm(heads(q)), l2norm(heads(k)), heads(v)
    beta = jax.nn.sigmoid(b.astype(jnp.float32))
    g = -jnp.exp(a_log.astype(jnp.float32)) * jax.nn.softplus(a.astype(jnp.float32) + dt_bias)
    o = gated_delta_rule(q, k, v, beta, g)
    o = rms_norm(o, norm_g) * jax.nn.silu(heads(z).astype(jnp.float32))
    return o.reshape(B, T, GDN_WIDTH).astype(qkv.dtype)


def compress(x, pos, w1, w2):
    B, T, H, D = x.shape
    R = CMP_LEN // CMP_STRIDE
    Nr = T // CMP_STRIDE
    r = x.reshape(B, Nr, CMP_STRIDE, H, D)
    blocks = jnp.concatenate([r[:, i:Nr - R + 1 + i] for i in range(R)], axis=2)
    blocks = blocks + pos[None, None, :, None, :]
    Nc = blocks.shape[1]
    flat = blocks.transpose(0, 1, 3, 2, 4).reshape(B, Nc, H, CMP_LEN * D)
    out = jax.nn.silu(flat @ w1) @ w2
    return out.transpose(0, 2, 1, 3)


def cmp_to_sel(p):
    R = SEL_BLOCK // CMP_STRIDE
    P = CMP_LEN // CMP_STRIDE - 1
    Ns = (p.shape[-1] + P) // R
    pp = jnp.pad(p, [(0, 0)] * (p.ndim - 1) + [(P, P)])
    return sum(lax.slice_in_dim(pp, o, o + R * (Ns - 1) + 1, stride=R, axis=-1) for o in range(R + P))


def nsa_mixer(q, kv, gate_logits, q_norm, k_norm, cmp_pos, cmp_w1, cmp_w2):
    B, T, _ = q.shape
    Hkv, G, Dh = NSA_KV_HEADS, NSA_GROUP, HEAD_DIM
    out_dtype = q.dtype
    scale = Dh ** -0.5
    q = rms_norm(q.reshape(B, T, NSA_HEADS, Dh), q_norm)
    q = q.reshape(B, T, Hkv, G, Dh).transpose(0, 2, 3, 1, 4)
    kc, vc, ks, vs, kw, vw = [t.reshape(B, T, Hkv, Dh) for t in jnp.split(kv, 6, axis=-1)]
    kc = rms_norm(compress(kc, cmp_pos[0], cmp_w1[0], cmp_w2[0]), k_norm[0])
    vc = compress(vc, cmp_pos[1], cmp_w1[1], cmp_w2[1])
    Nc = kc.shape[2]
    Ns = T // SEL_BLOCK
    K_SEL = min(SEL_TOPK, Ns)
    ks = rms_norm(ks, k_norm[1]).transpose(0, 2, 1, 3).reshape(B, Hkv, Ns, SEL_BLOCK, Dh)
    vs = vs.transpose(0, 2, 1, 3).reshape(B, Hkv, Ns, SEL_BLOCK, Dh)
    pad = ((0, 0), (0, 0), (WINDOW, 0), (0, 0))
    kw = jnp.pad(rms_norm(kw, k_norm[2]).transpose(0, 2, 1, 3), pad)
    vw = jnp.pad(vw.transpose(0, 2, 1, 3), pad)
    gates = jax.nn.sigmoid(gate_logits.astype(jnp.float32)).reshape(B, T, Hkv, G, 3).transpose(0, 2, 3, 1, 4)
    cmp_end = jnp.arange(Nc) * CMP_STRIDE + CMP_LEN - 1
    blk = jnp.arange(Ns)
    bidx = jnp.arange(B)[:, None, None, None]
    hidx = jnp.arange(Hkv)[None, :, None, None]

    def block(i):
        t0 = i * Q_BLOCK
        pos = t0 + jnp.arange(Q_BLOCK)
        qb = lax.dynamic_slice_in_dim(q, t0, Q_BLOCK, axis=3) * scale
        gb = lax.dynamic_slice_in_dim(gates, t0, Q_BLOCK, axis=3)
        s = jnp.einsum('bhgqd,bhcd->bhgqc', qb, kc)
        p_c = masked_softmax(s, cmp_end[None, :] <= pos[:, None])
        o_c = jnp.einsum('bhgqc,bhcd->bhgqd', p_c, vc)
        imp = cmp_to_sel(p_c.sum(axis=2))
        cur = pos // SEL_BLOCK
        forced = (blk[None] == 0) | (blk[None] == cur[:, None]) | (blk[None] == cur[:, None] - 1)
        valid = blk[None] * SEL_BLOCK <= pos[:, None]
        imp = jnp.where(forced, FORCED_SCORE, jnp.where(valid, imp, -1.0))
        _, idx = lax.top_k(imp, K_SEL)
        ksel = ks[bidx, hidx, idx]
        vsel = vs[bidx, hidx, idx].reshape(B, Hkv, Q_BLOCK, K_SEL * SEL_BLOCK, Dh)
        s = jnp.einsum('bhgqd,bhqksd->bhgqks', qb, ksel).reshape(B, Hkv, G, Q_BLOCK, K_SEL * SEL_BLOCK)
        key_pos = idx[..., None] * SEL_BLOCK + jnp.arange(SEL_BLOCK)
        mask_s = (key_pos <= pos[:, None, None]).reshape(B, Hkv, 1, Q_BLOCK, K_SEL * SEL_BLOCK)
        o_s = jnp.einsum('bhgqn,bhqnd->bhgqd', masked_softmax(s, mask_s), vsel)
        kwb = lax.dynamic_slice_in_dim(kw, t0, Q_BLOCK + WINDOW, axis=2)
        vwb = lax.dynamic_slice_in_dim(vw, t0, Q_BLOCK + WINDOW, axis=2)
        kpos = t0 - WINDOW + jnp.arange(Q_BLOCK + WINDOW)
        mask_w = (kpos[None] <= pos[:, None]) & (kpos[None] > pos[:, None] - WINDOW) & (kpos[None] >= 0)
        s = jnp.einsum('bhgqd,bhkd->bhgqk', qb, kwb)
        o_w = jnp.einsum('bhgqk,bhkd->bhgqd', masked_softmax(s, mask_w), vwb)
        return gb[..., 0:1] * o_c + gb[..., 1:2] * o_s + gb[..., 2:3] * o_w

    out = lax.map(block, jnp.arange(T // Q_BLOCK))
    return out.transpose(1, 0, 4, 2, 3, 5).reshape(B, T, NSA_WIDTH).astype(out_dtype)


def pool_mixer(u, pool_w, pool_scale):
    B, T, _ = u.shape
    uf = u.astype(jnp.float32)
    c = jnp.pad(jnp.cumsum(uf, axis=1), ((0, 0), (1, 0), (0, 0)))
    t1 = jnp.arange(1, T + 1, dtype=jnp.float32)
    outs = []
    for gi, w in enumerate(POOL_WINDOWS):
        sl = slice(gi * POOL_GROUP_DIM, (gi + 1) * POOL_GROUP_DIM)
        cg = c[..., sl]
        cg_lag = jnp.pad(cg, ((0, 0), (w - 1, 0), (0, 0)))[:, :T]
        mean = (cg[:, 1:] - cg_lag) / jnp.minimum(t1, float(w))[None, :, None]
        outs.append(jnp.einsum('btc,cd->btd', mean - uf[..., sl], pool_w[gi]))
    return (jnp.concatenate(outs, axis=-1) * pool_scale).astype(u.dtype)


def setup_inputs(seed: int = 0) -> dict:
    key = jax.random.key(seed)
    keys = jax.random.split(key, 20)
    nrm = lambda k, shape, s: jax.random.normal(k, shape, jnp.float32) * s
    L = DEPTH
    x = nrm(keys[0], (BATCH, SEQ, D_MODEL), 1.0)
    norm_mix = 1.0 + nrm(keys[1], (L, D_MODEL), 0.02)
    w_in = nrm(keys[2], (L, D_MODEL, D_IN), D_MODEL ** -0.5)
    conv_w = nrm(keys[3], (L, GDN_CONV, 3 * GDN_WIDTH), GDN_CONV ** -0.5)
    a_log = jnp.log(jax.random.uniform(keys[4], (L, GDN_HEADS), jnp.float32, 1.0, 16.0))
    dt = jnp.exp(jax.random.uniform(keys[5], (L, GDN_HEADS), jnp.float32, math.log(1e-3), math.log(1e-1)))
    dt_bias = dt + jnp.log(-jnp.expm1(-dt))
    gdn_norm = 1.0 + nrm(keys[6], (L, HEAD_DIM), 0.02)
    nsa_q_norm = 1.0 + nrm(keys[7], (L, HEAD_DIM), 0.02)
    nsa_k_norm = 1.0 + nrm(keys[8], (L, 3, HEAD_DIM), 0.02)
    cmp_pos = nrm(keys[9], (L, 2, CMP_LEN, HEAD_DIM), 0.1)
    cmp_w1 = nrm(keys[10], (L, 2, CMP_LEN * HEAD_DIM, CMP_HIDDEN), (CMP_LEN * HEAD_DIM) ** -0.5)
    cmp_w2 = nrm(keys[11], (L, 2, CMP_HIDDEN, HEAD_DIM), CMP_HIDDEN ** -0.5)
    pool_w = nrm(keys[12], (L, len(POOL_WINDOWS), POOL_GROUP_DIM, POOL_GROUP_DIM), POOL_GROUP_DIM ** -0.5)
    pool_scale = 1.0 + nrm(keys[13], (L, POOL_WIDTH), 0.1)
    w_out = nrm(keys[14], (L, D_MIX, D_MODEL), (2 * DEPTH * D_MIX) ** -0.5)
    norm_ffn = 1.0 + nrm(keys[15], (L, D_MODEL), 0.02)
    w_ffn1 = nrm(keys[16], (L, D_MODEL, D_FF), D_MODEL ** -0.5)
    w_ffn2 = nrm(keys[17], (L, D_FF, D_MODEL), (2 * DEPTH * D_FF) ** -0.5)
    return {"x": x, "norm_mix": norm_mix, "w_in": w_in, "conv_w": conv_w, "a_log": a_log, "dt_bias": dt_bias,
            "gdn_norm": gdn_norm, "nsa_q_norm": nsa_q_norm, "nsa_k_norm": nsa_k_norm, "cmp_pos": cmp_pos,
            "cmp_w1": cmp_w1, "cmp_w2": cmp_w2, "pool_w": pool_w, "pool_scale": pool_scale, "w_out": w_out,
            "norm_ffn": norm_ffn, "w_ffn1": w_ffn1, "w_ffn2": w_ffn2}


def reference(x, norm_mix, w_in, conv_w, a_log, dt_bias, gdn_norm, nsa_q_norm, nsa_k_norm, cmp_pos,
              cmp_w1, cmp_w2, pool_w, pool_scale, w_out, norm_ffn, w_ffn1, w_ffn2):
    for l in range(DEPTH):
        h = rms_norm(x, norm_mix[l])
        proj = h @ w_in[l]
        qkv_a, z_a, b_a, a_a, q_b, kv_b, gate_b, u_c = split_columns(proj)
        y_a = gdn_mixer(qkv_a, z_a, b_a, a_a, conv_w[l], a_log[l], dt_bias[l], gdn_norm[l])
        y_b = nsa_mixer(q_b, kv_b, gate_b, nsa_q_norm[l], nsa_k_norm[l], cmp_pos[l], cmp_w1[l], cmp_w2[l])
        y_c = pool_mixer(u_c, pool_w[l], pool_scale[l])
        y = jnp.concatenate([y_a.astype(x.dtype), y_b.astype(x.dtype), y_c.astype(x.dtype)], axis=-1)
        x = x + y @ w_out[l]
        h = rms_norm(x, norm_ffn[l])
        x = x + jnp.square(jax.nn.relu(h @ w_ffn1[l])) @ w_ffn2[l]
    return x
```

```cpp
#include <hip/hip_runtime.h>
#include <hip/hip_cooperative_groups.h>
#include <cstdio>
#include <cstdint>
namespace cg = cooperative_groups;

#ifndef MEGA
#define MEGA 0
#endif

typedef unsigned short bf16_t;
typedef short bf16x8 __attribute__((ext_vector_type(8)));
typedef float f32x4 __attribute__((ext_vector_type(4)));
typedef unsigned u32x4 __attribute__((ext_vector_type(4)));
typedef unsigned u32x2 __attribute__((ext_vector_type(2)));
#define DI __device__ __forceinline__

constexpr int T_ = 16384, NB = 2, NTOK = 32768, DM = 1024, DINO = 2974, DINP = 3072, DFF = 4096;
constexpr int C_QKV = 0, C_Z = 1152, C_BA = 1536, C_QB = 1600, C_KV = 1984, C_GATE = 2752, C_UC = 2816;
constexpr int LDS_BYTES = 73728;
constexpr int REC = 40960;
constexpr int NSCAN = 12;

struct Params {
    const float* x; const float* norm_mix; const float* w_in; const float* conv_w; const float* a_log; const float* dt_bias;
    const float* gdn_norm; const float* q_norm; const float* k_norm; const float* cmp_pos; const float* cmp_w1; const float* cmp_w2;
    const float* pool_w; const float* pool_scale; const float* w_out; const float* norm_ffn; const float* w_ffn1; const float* w_ffn2;
    float* out;
    bf16_t* wb_in; bf16_t* wb_out; bf16_t* wb_f1; bf16_t* wb_f2; bf16_t* wb_c1; bf16_t* wb_c2;
    bf16_t* hy;
    bf16_t* proj;
    bf16_t* hid;
    char* rec;
    float* glast;
    float* side;
    bf16_t* qn;
    bf16_t* ksn; bf16_t* kwn;
    bf16_t* vst; bf16_t* vwt;
    bf16_t* kc;
    bf16_t* vct;
};

DI float bf2f(bf16_t v) { return __uint_as_float(((unsigned)v) << 16); }
DI bf16_t f2bf(float x) { unsigned u = __float_as_uint(x); u += 0x7fffu + ((u >> 16) & 1u); return (bf16_t)(u >> 16); }
typedef __bf16 bf16x2_t __attribute__((ext_vector_type(2)));
typedef float f32x2 __attribute__((ext_vector_type(2)));
DI unsigned pk2(float lo, float hi) { f32x2 v = {lo, hi}; bf16x2_t r = __builtin_convertvector(v, bf16x2_t); return __builtin_bit_cast(unsigned, r); }
DI f32x4 mfma(bf16x8 a, bf16x8 b, f32x4 c) { return __builtin_amdgcn_mfma_f32_16x16x32_bf16(a, b, c, 0, 0, 0); }
DI bf16x8 pack2(f32x4 a, f32x4 b) {
    u32x4 r; r[0] = pk2(a[0], a[1]); r[1] = pk2(a[2], a[3]); r[2] = pk2(b[0], b[1]); r[3] = pk2(b[2], b[3]);
    return __builtin_bit_cast(bf16x8, r);
}
DI int PERM(int p) { return (p & ~31) + 16 * ((p >> 2) & 1) + 4 * ((p >> 3) & 3) + (p & 3); }
DI int PINV(int s) { return (s & ~31) | ((s & 12) << 1) | ((s & 16) >> 2) | (s & 3); }
DI float sigmoidf_(float x) { return 1.f / (1.f + __expf(-x)); }
DI float siluf_(float x) { return x / (1.f + __expf(-x)); }

DI void cvt_job(const float* src, bf16_t* dst, int K, int Nn, int NnPad, int remap, char* smem) {
    float* tile = (float*)smem;
    const int tid = threadIdx.x;
    const int nkt = K / 64, items = nkt * (NnPad / 64);
    for (int it = blockIdx.x; it < items; it += gridDim.x) {
        const int kt = it % nkt, nt = it / nkt;
        {
            const int c = tid & 63, r = tid >> 6;
            const int nn = nt * 64 + c;
            int no = nn;
            if (remap) { no = nn < 1548 ? nn : (nn < 1600 ? -1 : (nn < 2770 ? nn - 52 : (nn < 2816 ? -1 : nn - 98))); }
            if (no >= Nn) no = -1;
#pragma unroll
            for (int i = 0; i < 16; ++i) {
                const int k = r + 4 * i;
                tile[k * 65 + c] = (no >= 0) ? src[(size_t)(kt * 64 + k) * Nn + no] : 0.f;
            }
        }
        __syncthreads();
        {
            const int nl = tid >> 2, part = tid & 3;
            u32x4 v0, v1;
#pragma unroll
            for (int j = 0; j < 4; ++j) {
                v0[j] = pk2(tile[(part * 16 + 2 * j) * 65 + nl], tile[(part * 16 + 2 * j + 1) * 65 + nl]);
                v1[j] = pk2(tile[(part * 16 + 8 + 2 * j) * 65 + nl], tile[(part * 16 + 8 + 2 * j + 1) * 65 + nl]);
            }
            bf16_t* d = dst + (size_t)(nt * 64 + nl) * K + kt * 64 + part * 16;
            *(u32x4*)d = v0; *(u32x4*)(d + 8) = v1;
        }
        __syncthreads();
    }
}
DI void phase_convert(const Params& p, char* smem) {
    for (int l = 0; l < 2; ++l) {
        cvt_job(p.w_in + (size_t)l * DM * DINO, p.wb_in + (size_t)l * DINP * DM, DM, DINO, DINP, 1, smem);
        cvt_job(p.w_out + (size_t)l * DM * DM, p.wb_out + (size_t)l * DM * DM, DM, DM, DM, 0, smem);
        cvt_job(p.w_ffn1 + (size_t)l * DM * DFF, p.wb_f1 + (size_t)l * DFF * DM, DM, DFF, DFF, 0, smem);
        cvt_job(p.w_ffn2 + (size_t)l * DFF * DM, p.wb_f2 + (size_t)l * DM * DFF, DFF, DM, DM, 0, smem);
        for (int kv = 0; kv < 2; ++kv) {
            cvt_job(p.cmp_w1 + (size_t)(l * 2 + kv) * 2048 * 256, p.wb_c1 + (size_t)(l * 2 + kv) * 256 * 2048, 2048, 256, 256, 0, smem);
            cvt_job(p.cmp_w2 + (size_t)(l * 2 + kv) * 256 * 64, p.wb_c2 + (size_t)(l * 2 + kv) * 64 * 256, 256, 64, 64, 0, smem);
        }
    }
}

DI void phase_rmsnorm(const float* X, const float* g, bf16_t* H) {
    const int lane = threadIdx.x & 63, wave = threadIdx.x >> 6;
    for (int row = blockIdx.x * 4 + wave; row < NTOK; row += gridDim.x * 4) {
        const float* xr = X + (size_t)row * DM;
        f32x4 v[4]; float ss = 0.f;
#pragma unroll
        for (int i = 0; i < 4; ++i) { v[i] = *(const f32x4*)(xr + i * 256 + lane * 4); ss += v[i][0] * v[i][0] + v[i][1] * v[i][1] + v[i][2] * v[i][2] + v[i][3] * v[i][3]; }
#pragma unroll
        for (int o = 32; o >= 1; o >>= 1) ss += __shfl_xor(ss, o);
        const float r = rsqrtf(ss * (1.f / DM) + 1e-6f);
#pragma unroll
        for (int i = 0; i < 4; ++i) {
            const f32x4 gg = *(const f32x4*)(g + i * 256 + lane * 4);
            u32x2 o2; o2[0] = pk2(v[i][0] * r * gg[0], v[i][1] * r * gg[1]); o2[1] = pk2(v[i][2] * r * gg[2], v[i][3] * r * gg[3]);
            *(u32x2*)(H + (size_t)row * DM + i * 256 + lane * 4) = o2;
        }
    }
}

template <int EPI>
DI void gemm_phase(const bf16_t* __restrict__ A, const bf16_t* __restrict__ Bt, int M, int Nn, int K,
                   bf16_t* outb, float* side, const float* xin, float* xout, char* smem) {
    const int tid = threadIdx.x, lane = tid & 63, wave = tid >> 6, wr = wave >> 1, wc = wave & 1, fr = lane & 15, fq = lane >> 4;
    const int nNt = Nn / 128, nTiles = (M / 128) * nNt, nk = K / 64;
    bf16_t* sA = (bf16_t*)smem;
    bf16_t* sB = sA + 2 * 128 * 72;
    for (int tile = blockIdx.x; tile < nTiles; tile += gridDim.x) {
        const int mt = tile / nNt, nt = tile % nNt;
        const bf16_t* Ag = A + (size_t)(mt * 128) * K;
        const bf16_t* Bg = Bt + (size_t)(nt * 128) * K;
        f32x4 acc[4][4];
#pragma unroll
        for (int i = 0; i < 4; ++i)
#pragma unroll
            for (int j = 0; j < 4; ++j) acc[i][j] = (f32x4){0.f, 0.f, 0.f, 0.f};
        u32x4 ra[4], rb[4];
#pragma unroll
        for (int i = 0; i < 4; ++i) {
            const int cid = tid + 256 * i, row = cid >> 3, cc = cid & 7;
            ra[i] = *(const u32x4*)(Ag + (size_t)row * K + cc * 8);
            rb[i] = *(const u32x4*)(Bg + (size_t)row * K + cc * 8);
        }
#pragma unroll
        for (int i = 0; i < 4; ++i) {
            const int cid = tid + 256 * i, row = cid >> 3, cc = cid & 7;
            *(u32x4*)(sA + row * 72 + cc * 8) = ra[i];
            *(u32x4*)(sB + row * 72 + cc * 8) = rb[i];
        }
        __syncthreads();
        for (int kt = 0; kt < nk; ++kt) {
            const int buf = kt & 1;
            if (kt + 1 < nk) {
#pragma unroll
                for (int i = 0; i < 4; ++i) {
                    const int cid = tid + 256 * i, row = cid >> 3, cc = cid & 7;
                    ra[i] = *(const u32x4*)(Ag + (size_t)row * K + (kt + 1) * 64 + cc * 8);
                    rb[i] = *(const u32x4*)(Bg + (size_t)row * K + (kt + 1) * 64 + cc * 8);
                }
            }
            const bf16_t* a_ = sA + buf * 128 * 72;
            const bf16_t* b_ = sB + buf * 128 * 72;
#pragma unroll
            for (int ks = 0; ks < 2; ++ks) {
                bf16x8 af[4], bfr[4];
#pragma unroll
                for (int i = 0; i < 4; ++i) af[i] = *(const bf16x8*)(a_ + (wr * 64 + i * 16 + fr) * 72 + ks * 32 + fq * 8);
#pragma unroll
                for (int j = 0; j < 4; ++j) bfr[j] = *(const bf16x8*)(b_ + (wc * 64 + j * 16 + fr) * 72 + ks * 32 + fq * 8);
#pragma unroll
                for (int i = 0; i < 4; ++i)
#pragma unroll
                    for (int j = 0; j < 4; ++j) acc[i][j] = mfma(bfr[j], af[i], acc[i][j]);
            }
            if (kt + 1 < nk) {
                bf16_t* a2 = sA + (buf ^ 1) * 128 * 72;
                bf16_t* b2 = sB + (buf ^ 1) * 128 * 72;
#pragma unroll
                for (int i = 0; i < 4; ++i) {
                    const int cid = tid + 256 * i, row = cid >> 3, cc = cid & 7;
                    *(u32x4*)(a2 + row * 72 + cc * 8) = ra[i];
                    *(u32x4*)(b2 + row * 72 + cc * 8) = rb[i];
                }
            }
            __syncthreads();
        }
#pragma unroll
        for (int i = 0; i < 4; ++i) {
            const int m = mt * 128 + wr * 64 + i * 16 + fr;
#pragma unroll
            for (int j = 0; j < 4; ++j) {
                const int n = nt * 128 + wc * 64 + j * 16 + fq * 4;
                f32x4 v = acc[i][j];
                if (EPI == 0) {
                    u32x2 o2; o2[0] = pk2(v[0], v[1]); o2[1] = pk2(v[2], v[3]);
                    *(u32x2*)(outb + (size_t)m * Nn + n) = o2;
                    if (n >= C_BA && n < C_BA + 12) *(f32x4*)(side + (size_t)m * 12 + (n - C_BA)) = v;
                } else if (EPI == 1) {
#pragma unroll
                    for (int e = 0; e < 4; ++e) { const float r = fmaxf(v[e], 0.f); v[e] = r * r; }
                    u32x2 o2; o2[0] = pk2(v[0], v[1]); o2[1] = pk2(v[2], v[3]);
                    *(u32x2*)(outb + (size_t)m * Nn + n) = o2;
                } else {
                    const f32x4 xi = *(const f32x4*)(xin + (size_t)m * Nn + n);
                    *(f32x4*)(xout + (size_t)m * Nn + n) = xi + v;
                }
            }
        }
    }
}

DI void phase_gdn_prep(const Params& p, int l, char* smem) {
    float* sq = (float*)smem; float* sk = sq + 64 * 65; float* sv = sk + 64 * 65; float* sL = sv + 64 * 65;
    float* sgc = sL + 64 * 64; float* sbeta = sgc + 64;
    const int tid = threadIdx.x, lane = tid & 63;
    const float* cw = p.conv_w + (size_t)l * 4 * 1152;
    for (int item = blockIdx.x; item < 3072; item += gridDim.x) {
        const int chunk = item & 255, bh = item >> 8, h = bh % 6, b = bh / 6;
        const int tb0 = chunk * 64; const size_t row0 = (size_t)b * T_ + tb0;
        char* rec = p.rec + (size_t)item * REC;
        {
            const int ch = tid & 63, tq = tid >> 6;
#pragma unroll
            for (int part = 0; part < 3; ++part) {
                const int col = part * 384 + h * 64 + ch;
                const float w0 = cw[col], w1 = cw[1152 + col], w2 = cw[2 * 1152 + col], w3 = cw[3 * 1152 + col];
                float* dst = part == 0 ? sq : (part == 1 ? sk : sv);
                for (int i = 0; i < 16; ++i) {
                    const int t = tq + 4 * i, tb = tb0 + t;
                    const bf16_t* pr = p.proj + (row0 + t) * DINP + col;
                    const float x3 = bf2f(pr[0]);
                    const float x2 = tb >= 1 ? bf2f(pr[-DINP]) : 0.f;
                    const float x1 = tb >= 2 ? bf2f(pr[-2 * DINP]) : 0.f;
                    const float x0 = tb >= 3 ? bf2f(pr[-3 * DINP]) : 0.f;
                    const float a = x0 * w0 + x1 * w1 + x2 * w2 + x3 * w3;
                    dst[t * 65 + ch] = siluf_(a);
                }
            }
        }
        if (tid < 64) {
            const float bb = p.side[(row0 + tid) * 12 + h], aa = p.side[(row0 + tid) * 12 + 6 + h];
            const float xx = aa + p.dt_bias[l * 6 + h];
            const float sp = xx > 20.f ? xx : log1pf(expf(xx));
            float g = -expf(p.a_log[l * 6 + h]) * sp;
#pragma unroll
            for (int off = 1; off < 64; off <<= 1) { const float v = __shfl_up(g, off); if (lane >= off) g += v; }
            sgc[tid] = g; sbeta[tid] = 1.f / (1.f + expf(-bb));
            if (tid == 63) p.glast[item] = expf(g);
        }
        __syncthreads();
        {
            const int t = tid >> 2, part = tid & 3;
            float s1 = 0.f, s2 = 0.f;
#pragma unroll
            for (int j = 0; j < 16; ++j) { const float a = sq[t * 65 + part * 16 + j], c = sk[t * 65 + part * 16 + j]; s1 += a * a; s2 += c * c; }
            s1 += __shfl_xor(s1, 1); s1 += __shfl_xor(s1, 2); s2 += __shfl_xor(s2, 1); s2 += __shfl_xor(s2, 2);
            const float r1 = rsqrtf(s1 + 1e-6f) * 0.125f, r2 = rsqrtf(s2 + 1e-6f);
#pragma unroll
            for (int j = 0; j < 16; ++j) { sq[t * 65 + part * 16 + j] *= r1; sk[t * 65 + part * 16 + j] *= r2; }
        }
        __syncthreads();
        {
            const int ci = tid >> 4, si = tid & 15;
            float kk[4][4], qk[4][4];
#pragma unroll
            for (int i = 0; i < 4; ++i)
#pragma unroll
                for (int j = 0; j < 4; ++j) { kk[i][j] = 0.f; qk[i][j] = 0.f; }
            for (int d = 0; d < 64; ++d) {
                float kc_[4], ks_[4], qc_[4];
#pragma unroll
                for (int i = 0; i < 4; ++i) { kc_[i] = sk[(4 * ci + i) * 65 + d]; ks_[i] = sk[(4 * si + i) * 65 + d]; qc_[i] = sq[(4 * ci + i) * 65 + d]; }
#pragma unroll
                for (int i = 0; i < 4; ++i)
#pragma unroll
                    for (int j = 0; j < 4; ++j) { kk[i][j] += kc_[i] * ks_[j]; qk[i][j] += qc_[i] * ks_[j]; }
            }
#pragma unroll
            for (int i = 0; i < 4; ++i) {
                const int c = 4 * ci + i;
                float qv[4];
#pragma unroll
                for (int j = 0; j < 4; ++j) {
                    const int s = 4 * si + j;
                    const float e = (s <= c) ? __expf(sgc[c] - sgc[s]) : 0.f;
                    sL[c * 64 + s] = (s < c) ? sbeta[c] * kk[i][j] * e : 0.f;
                    qv[j] = qk[i][j] * e;
                }
                u32x2 o2; o2[0] = pk2(qv[0], qv[1]); o2[1] = pk2(qv[2], qv[3]);
                *(u32x2*)(rec + 16384 + (c * 64 + PINV(4 * si)) * 2) = o2;
            }
        }
        {
            const int r = tid >> 2, part = tid & 3;
            const float eg = __expf(sgc[r]);
            u32x4 v0, v1, w0, w1;
#pragma unroll
            for (int j = 0; j < 8; ++j) {
                const int p0 = part * 16 + 2 * j, p1 = p0 + 1;
                const unsigned a = pk2(sq[r * 65 + PERM(p0)] * eg, sq[r * 65 + PERM(p1)] * eg);
                const int c0 = PERM(p0), c1 = PERM(p1);
                const unsigned c = pk2(sk[c0 * 65 + r] * __expf(sgc[63] - sgc[c0]), sk[c1 * 65 + r] * __expf(sgc[63] - sgc[c1]));
                if (j < 4) { v0[j] = a; w0[j] = c; } else { v1[j - 4] = a; w1[j - 4] = c; }
            }
            *(u32x4*)(rec + 8192 + (r * 64 + part * 16) * 2) = v0; *(u32x4*)(rec + 8192 + (r * 64 + part * 16 + 8) * 2) = v1;
            *(u32x4*)(rec + 24576 + (r * 64 + part * 16) * 2) = w0; *(u32x4*)(rec + 24576 + (r * 64 + part * 16 + 8) * 2) = w1;
        }
        __syncthreads();
        {
            const int t = tid >> 2, part = tid & 3;
            const float bt = sbeta[t], be = bt * __expf(sgc[t]);
#pragma unroll
            for (int j = 0; j < 16; ++j) { sv[t * 65 + part * 16 + j] *= bt; sk[t * 65 + part * 16 + j] *= be; }
        }
        __syncthreads();
        if (tid < 128) {
            float* X = (tid < 64) ? sv : sk; const int col = tid & 63;
            for (int c = 1; c < 64; ++c) {
                float acc = X[c * 65 + col];
                const float* Lr = sL + c * 64;
#pragma unroll 4
                for (int s = 0; s < c; ++s) acc -= Lr[s] * X[s * 65 + col];
                X[c * 65 + col] = acc;
            }
        }
        __syncthreads();
        {
            const int r = tid >> 2, part = tid & 3;
            u32x4 v0, v1, w0, w1;
#pragma unroll
            for (int j = 0; j < 8; ++j) {
                const int p0 = part * 16 + 2 * j, p1 = p0 + 1;
                const unsigned a = pk2(sk[r * 65 + PERM(p0)], sk[r * 65 + PERM(p1)]);
                const unsigned c = pk2(sv[p0 * 65 + r], sv[p1 * 65 + r]);
                if (j < 4) { v0[j] = a; w0[j] = c; } else { v1[j - 4] = a; w1[j - 4] = c; }
            }
            *(u32x4*)(rec + (r * 64 + part * 16) * 2) = v0; *(u32x4*)(rec + (r * 64 + part * 16 + 8) * 2) = v1;
            *(u32x4*)(rec + 32768 + (r * 64 + part * 16) * 2) = w0; *(u32x4*)(rec + 32768 + (r * 64 + part * 16 + 8) * 2) = w1;
        }
        __syncthreads();
    }
}

DI void gdn_scan_block(const Params& p, int bh, char* smem) {
    const int tid = threadIdx.x, lane = tid & 63, wave = tid >> 6, fr = lane & 15, fq = lane >> 4;
    const int h = bh % 6, b = bh / 6, e0 = wave * 16;
    const char* recs = p.rec + (size_t)bh * 256 * REC;
    u32x4 st[8];
#pragma unroll
    for (int i = 0; i < 8; ++i) { const int cid = tid + 256 * i; st[i] = *(const u32x4*)(recs + cid * 16); }
#pragma unroll
    for (int i = 0; i < 8; ++i) { const int cid = tid + 256 * i, mat = cid >> 9, row = (cid >> 3) & 63, cc = cid & 7; *(u32x4*)(smem + mat * 9216 + row * 144 + cc * 16) = st[i]; }
    u32x2 un[4];
#pragma unroll
    for (int ct = 0; ct < 4; ++ct) un[ct] = *(const u32x2*)(recs + 32768 + ((e0 + fr) * 64 + ct * 16 + fq * 4) * 2);
    float gl_n = p.glast[bh * 256];
    __syncthreads();
    f32x4 S[4];
#pragma unroll
    for (int i = 0; i < 4; ++i) S[i] = (f32x4){0.f, 0.f, 0.f, 0.f};
    for (int ck = 0; ck < 256; ++ck) {
        const char* buf = smem + (ck & 1) * 36864;
        u32x2 uc[4];
#pragma unroll
        for (int ct = 0; ct < 4; ++ct) uc[ct] = un[ct];
        const float gl = gl_n;
        if (ck + 1 < 256) {
            const char* rn = recs + (size_t)(ck + 1) * REC;
#pragma unroll
            for (int i = 0; i < 8; ++i) { const int cid = tid + 256 * i; st[i] = *(const u32x4*)(rn + cid * 16); }
#pragma unroll
            for (int ct = 0; ct < 4; ++ct) un[ct] = *(const u32x2*)(rn + 32768 + ((e0 + fr) * 64 + ct * 16 + fq * 4) * 2);
            gl_n = p.glast[bh * 256 + ck + 1];
        }
        const bf16x8 Sb0 = pack2(S[0], S[1]), Sb1 = pack2(S[2], S[3]);
        f32x4 vn[4];
#pragma unroll
        for (int ct = 0; ct < 4; ++ct) {
            const bf16x8 a0 = *(const bf16x8*)(buf + (ct * 16 + fr) * 144 + fq * 16);
            const bf16x8 a1 = *(const bf16x8*)(buf + (ct * 16 + fr) * 144 + 64 + fq * 16);
            f32x4 acc = (f32x4){0.f, 0.f, 0.f, 0.f};
            acc = mfma(a0, Sb0, acc); acc = mfma(a1, Sb1, acc);
            f32x4 u; u[0] = __uint_as_float(uc[ct][0] << 16); u[1] = __uint_as_float(uc[ct][0] & 0xffff0000u);
            u[2] = __uint_as_float(uc[ct][1] << 16); u[3] = __uint_as_float(uc[ct][1] & 0xffff0000u);
            vn[ct] = u - acc;
        }
        const bf16x8 vb0 = pack2(vn[0], vn[1]), vb1 = pack2(vn[2], vn[3]);
        const size_t nrow0 = (size_t)b * T_ + ck * 64;
#pragma unroll
        for (int ct = 0; ct < 4; ++ct) {
            const char* qd = buf + 9216 + (ct * 16 + fr) * 144 + fq * 16;
            const char* qk = buf + 18432 + (ct * 16 + fr) * 144 + fq * 16;
            f32x4 o = (f32x4){0.f, 0.f, 0.f, 0.f};
            o = mfma(*(const bf16x8*)qd, Sb0, o); o = mfma(*(const bf16x8*)(qd + 64), Sb1, o);
            o = mfma(*(const bf16x8*)qk, vb0, o); o = mfma(*(const bf16x8*)(qk + 64), vb1, o);
#pragma unroll
            for (int ii = 0; ii < 4; ++ii) p.hy[(nrow0 + ct * 16 + fq * 4 + ii) * DM + h * 64 + e0 + fr] = f2bf(o[ii]);
        }
#pragma unroll
        for (int dt = 0; dt < 4; ++dt) {
            const char* kd = buf + 27648 + (dt * 16 + fr) * 144 + fq * 16;
            f32x4 s = S[dt] * gl;
            s = mfma(*(const bf16x8*)kd, vb0, s); s = mfma(*(const bf16x8*)(kd + 64), vb1, s);
            S[dt] = s;
        }
        if (ck + 1 < 256) {
            char* nb = smem + ((ck + 1) & 1) * 36864;
#pragma unroll
            for (int i = 0; i < 8; ++i) { const int cid = tid + 256 * i, mat = cid >> 9, row = (cid >> 3) & 63, cc = cid & 7; *(u32x4*)(nb + mat * 9216 + row * 144 + cc * 16) = st[i]; }
        }
        __syncthreads();
    }
}

DI void phase_gdn_final(const Params& p, int l) {
    const int lane = threadIdx.x & 63, wave = threadIdx.x >> 6;
    const float gn = p.gdn_norm[l * 64 + lane];
    for (int it = blockIdx.x * 4 + wave; it < NTOK * 6; it += gridDim.x * 4) {
        const int n = it / 6, h = it % 6;
        bf16_t* yp = p.hy + (size_t)n * DM + h * 64 + lane;
        const float o = bf2f(*yp);
        float ss = o * o;
#pragma unroll
        for (int s = 32; s >= 1; s >>= 1) ss += __shfl_xor(ss, s);
        const float r = rsqrtf(ss * (1.f / 64.f) + 1e-6f);
        const float z = bf2f(p.proj[(size_t)n * DINP + C_Z + h * 64 + lane]);
        *yp = f2bf(o * r * gn * siluf_(z));
    }
}

DI void phase_nsa_prep(const Params& p, int l, char* smem) {
    bf16_t* tr = (bf16_t*)smem;
    const int tid = threadIdx.x, t = tid >> 2, part = tid & 3;
    for (int item = blockIdx.x; item < NB * 2 * 256; item += gridDim.x) {
        const int blk = item & 255, kvh = (item >> 8) & 1, b = item >> 9;
        const size_t n = (size_t)b * T_ + blk * 64 + t;
        const bf16_t* pr = p.proj + n * DINP;
#pragma unroll
        for (int w = 0; w < 2; ++w) {
            const bf16_t* src = pr + C_KV + (w == 0 ? 256 : 512) + kvh * 64 + part * 16;
            const float* g = p.k_norm + (l * 3 + 1 + w) * 64 + part * 16;
            float v[16]; float ss = 0.f;
#pragma unroll
            for (int j = 0; j < 16; ++j) { v[j] = bf2f(src[j]); ss += v[j] * v[j]; }
            ss += __shfl_xor(ss, 1); ss += __shfl_xor(ss, 2);
            const float r = rsqrtf(ss * (1.f / 64.f) + 1e-6f);
            bf16_t* dst = (w == 0 ? p.ksn : p.kwn) + (((size_t)(b * 2 + kvh) * T_) + blk * 64 + t) * 64 + part * 16;
            u32x4 o0, o1;
#pragma unroll
            for (int j = 0; j < 4; ++j) { o0[j] = pk2(v[2 * j] * r * g[2 * j], v[2 * j + 1] * r * g[2 * j + 1]); o1[j] = pk2(v[8 + 2 * j] * r * g[8 + 2 * j], v[9 + 2 * j] * r * g[9 + 2 * j]); }
            *(u32x4*)dst = o0; *(u32x4*)(dst + 8) = o1;
        }
#pragma unroll
        for (int g3 = 0; g3 < 3; ++g3) {
            const int h = kvh * 3 + g3;
            const bf16_t* src = pr + C_QB + h * 64 + part * 16;
            const float* g = p.q_norm + l * 64 + part * 16;
            float v[16]; float ss = 0.f;
#pragma unroll
            for (int j = 0; j < 16; ++j) { v[j] = bf2f(src[j]); ss += v[j] * v[j]; }
            ss += __shfl_xor(ss, 1); ss += __shfl_xor(ss, 2);
            const float r = rsqrtf(ss * (1.f / 64.f) + 1e-6f) * 0.125f;
            bf16_t* dst = p.qn + (n * 6 + h) * 64 + part * 16;
            u32x4 o0, o1;
#pragma unroll
            for (int j = 0; j < 4; ++j) { o0[j] = pk2(v[2 * j] * r * g[2 * j], v[2 * j + 1] * r * g[2 * j + 1]); o1[j] = pk2(v[8 + 2 * j] * r * g[8 + 2 * j], v[9 + 2 * j] * r * g[9 + 2 * j]); }
            *(u32x4*)dst = o0; *(u32x4*)(dst + 8) = o1;
        }
#pragma unroll
        for (int w = 0; w < 2; ++w) {
            const bf16_t* src = pr + C_KV + (w == 0 ? 384 : 640) + kvh * 64 + part * 16;
#pragma unroll
            for (int j = 0; j < 16; ++j) tr[w * 64 * 66 + (part * 16 + j) * 66 + t] = src[j];
        }
        __syncthreads();
#pragma unroll
        for (int w = 0; w < 2; ++w) {
            const int d = t;
            u32x4 o0, o1;
#pragma unroll
            for (int j = 0; j < 8; ++j) {
                const int p0 = part * 16 + 2 * j;
                const unsigned a = (unsigned)tr[w * 64 * 66 + d * 66 + PERM(p0)] | ((unsigned)tr[w * 64 * 66 + d * 66 + PERM(p0 + 1)] << 16);
                if (j < 4) o0[j] = a; else o1[j - 4] = a;
            }
            bf16_t* dst = (w == 0 ? p.vst : p.vwt) + (((size_t)(b * 2 + kvh) * 256 + blk) * 64 + d) * 64 + part * 16;
            *(u32x4*)dst = o0; *(u32x4*)(dst + 8) = o1;
        }
        __syncthreads();
    }
}

DI void phase_compress(const Params& p, int l, int wave_id, int wave_stride) {
    const int lane = threadIdx.x & 63, fr = lane & 15, fq = lane >> 4;
    for (int item = wave_id; item < 512; item += wave_stride) {
        const int ci = item & 63, kvh = (item >> 6) & 1, b = (item >> 7) & 1, kv = item >> 8;
        const int c = ci * 16 + fr;
        const int cc = c > 1022 ? 1022 : c;
        const bf16_t* xr = p.proj + ((size_t)b * T_ + 16 * cc) * DINP + C_KV + kv * 128 + kvh * 64;
        const float* pos = p.cmp_pos + (size_t)(l * 2 + kv) * 32 * 64;
        const bf16_t* w1 = p.wb_c1 + (size_t)(l * 2 + kv) * 256 * 2048;
        const bf16_t* w2 = p.wb_c2 + (size_t)(l * 2 + kv) * 64 * 256;
        f32x4 acc[16];
#pragma unroll
        for (int i = 0; i < 16; ++i) acc[i] = (f32x4){0.f, 0.f, 0.f, 0.f};
        for (int ks = 0; ks < 64; ++ks) {
            const int t = ks >> 1, db = (ks & 1) * 32 + fq * 8;
            const u32x4 xv = *(const u32x4*)(xr + (size_t)t * DINP + db);
            const f32x4 p0 = *(const f32x4*)(pos + t * 64 + db), p1 = *(const f32x4*)(pos + t * 64 + db + 4);
            u32x4 xb;
            xb[0] = pk2(__uint_as_float(xv[0] << 16) + p0[0], __uint_as_float(xv[0] & 0xffff0000u) + p0[1]);
            xb[1] = pk2(__uint_as_float(xv[1] << 16) + p0[2], __uint_as_float(xv[1] & 0xffff0000u) + p0[3]);
            xb[2] = pk2(__uint_as_float(xv[2] << 16) + p1[0], __uint_as_float(xv[2] & 0xffff0000u) + p1[1]);
            xb[3] = pk2(__uint_as_float(xv[3] << 16) + p1[2], __uint_as_float(xv[3] & 0xffff0000u) + p1[3]);
            const bf16x8 bx = __builtin_bit_cast(bf16x8, xb);
#pragma unroll
            for (int nt = 0; nt < 16; ++nt) {
                const bf16x8 wf = *(const bf16x8*)(w1 + (size_t)(nt * 16 + fr) * 2048 + ks * 32 + fq * 8);
                acc[nt] = mfma(wf, bx, acc[nt]);
            }
        }
        f32x4 o[4];
#pragma unroll
        for (int i = 0; i < 4; ++i) o[i] = (f32x4){0.f, 0.f, 0.f, 0.f};
#pragma unroll
        for (int k2 = 0; k2 < 8; ++k2) {
            f32x4 a = acc[2 * k2], c2 = acc[2 * k2 + 1];
#pragma unroll
            for (int e = 0; e < 4; ++e) { a[e] = siluf_(a[e]); c2[e] = siluf_(c2[e]); }
            const bf16x8 hb = pack2(a, c2);
#pragma unroll
            for (int t2 = 0; t2 < 4; ++t2) {
                const bf16_t* wr = w2 + (size_t)(t2 * 16 + fr) * 256 + k2 * 32 + fq * 4;
                const u32x2 lo = *(const u32x2*)wr, hi = *(const u32x2*)(wr + 16);
                u32x4 wv; wv[0] = lo[0]; wv[1] = lo[1]; wv[2] = hi[0]; wv[3] = hi[1];
                o[t2] = mfma(__builtin_bit_cast(bf16x8, wv), hb, o[t2]);
            }
        }
        if (kv == 0) {
            float ss = 0.f;
#pragma unroll
            for (int t2 = 0; t2 < 4; ++t2)
#pragma unroll
                for (int e = 0; e < 4; ++e) ss += o[t2][e] * o[t2][e];
            ss += __shfl_xor(ss, 16); ss += __shfl_xor(ss, 32);
            const float r = (c <= 1022) ? rsqrtf(ss * (1.f / 64.f) + 1e-6f) : 0.f;
            const float* g = p.k_norm + (l * 3 + 0) * 64;
#pragma unroll
            for (int t2 = 0; t2 < 4; ++t2) {
                const int n2 = t2 * 16 + fq * 4;
                u32x2 o2; o2[0] = pk2(o[t2][0] * r * g[n2], o[t2][1] * r * g[n2 + 1]); o2[1] = pk2(o[t2][2] * r * g[n2 + 2], o[t2][3] * r * g[n2 + 3]);
                *(u32x2*)(p.kc + (((size_t)(b * 2 + kvh) * 1024) + c) * 64 + n2) = o2;
            }
        } else {
            const float z = (c <= 1022) ? 1.f : 0.f;
            bf16_t* dst = p.vct + ((size_t)(b * 2 + kvh) * 16 + (c >> 6)) * 4096 + PINV(c & 63);
#pragma unroll
            for (int t2 = 0; t2 < 4; ++t2)
#pragma unroll
                for (int e = 0; e < 4; ++e) dst[(t2 * 16 + fq * 4 + e) * 64] = f2bf(o[t2][e] * z);
        }
    }
}

DI void phase_pool(const Params& p, int l, char* smem) {
    float* su = (float*)smem;
    float* sd = su + 79 * 64;
    float* sw = sd + 64 * 65;
    const int tid = threadIdx.x;
    for (int item = blockIdx.x; item < 512 * 4; item += gridDim.x) {
        const int gi = item & 3, tile = item >> 2;
        const int w = 2 << gi;
        const size_t n0 = (size_t)tile * 64; const int tb0 = (int)(n0 & (T_ - 1));
        for (int i = tid; i < 79 * 64; i += 256) {
            const int r = i >> 6, c = i & 63; const int tb = tb0 - 15 + r;
            su[i] = tb >= 0 ? bf2f(p.proj[(n0 - 15 + r) * DINP + C_UC + gi * 64 + c]) : 0.f;
        }
        for (int i = tid; i < 4096; i += 256) sw[i] = p.pool_w[((size_t)(l * 4 + gi) * 64) * 64 + i];
        __syncthreads();
        for (int i = tid; i < 4096; i += 256) {
            const int t = i >> 6, c = i & 63; const int tb = tb0 + t;
            float s = 0.f;
            for (int k = 0; k < w; ++k) s += su[(15 + t - k) * 64 + c];
            const float cnt = (float)(tb + 1 < w ? tb + 1 : w);
            sd[t * 65 + c] = s / cnt - su[(15 + t) * 64 + c];
        }
        __syncthreads();
        {
            const int t = tid >> 2, dq = (tid & 3) * 16;
            float acc[16];
#pragma unroll
            for (int j = 0; j < 16; ++j) acc[j] = 0.f;
            for (int c = 0; c < 64; ++c) {
                const float dv = sd[t * 65 + c];
#pragma unroll
                for (int j = 0; j < 16; ++j) acc[j] += dv * sw[c * 64 + dq + j];
            }
            const float* sc = p.pool_scale + l * 256 + gi * 64 + dq;
            u32x4 o0, o1;
#pragma unroll
            for (int j = 0; j < 4; ++j) { o0[j] = pk2(acc[2 * j] * sc[2 * j], acc[2 * j + 1] * sc[2 * j + 1]); o1[j] = pk2(acc[8 + 2 * j] * sc[8 + 2 * j], acc[9 + 2 * j] * sc[9 + 2 * j]); }
            bf16_t* dst = p.hy + (n0 + t) * DM + 768 + gi * 64 + dq;
            *(u32x4*)dst = o0; *(u32x4*)(dst + 8) = o1;
        }
        __syncthreads();
    }
}

DI void st_tile(const bf16_t* Kp, const bf16x8 (&qf)[2], int fr, int fq, f32x4 (&st)[4]) {
#pragma unroll
    for (int k4 = 0; k4 < 4; ++k4) {
        const bf16_t* kr = Kp + (k4 * 16 + fr) * 64 + fq * 8;
        f32x4 a = (f32x4){0.f, 0.f, 0.f, 0.f};
        a = mfma(*(const bf16x8*)kr, qf[0], a); a = mfma(*(const bf16x8*)(kr + 32), qf[1], a);
        st[k4] = a;
    }
}
DI void pv_tile(const bf16_t* VTp, const f32x4 (&pt)[4], int fr, int fq, f32x4 (&o)[4]) {
    const bf16x8 pb0 = pack2(pt[0], pt[1]), pb1 = pack2(pt[2], pt[3]);
#pragma unroll
    for (int dt = 0; dt < 4; ++dt) {
        const bf16_t* vr = VTp + (dt * 16 + fr) * 64 + fq * 8;
        o[dt] = mfma(*(const bf16x8*)vr, pb0, o[dt]); o[dt] = mfma(*(const bf16x8*)(vr + 32), pb1, o[dt]);
    }
}
DI void online_step(f32x4 (&st)[4], unsigned vmask, float& m, float& lsum, f32x4 (&o)[4]) {
    float tmax = -1e30f;
#pragma unroll
    for (int k4 = 0; k4 < 4; ++k4)
#pragma unroll
        for (int ii = 0; ii < 4; ++ii) if (vmask & (1u << (k4 * 4 + ii))) tmax = fmaxf(tmax, st[k4][ii]);
    tmax = fmaxf(tmax, __shfl_xor(tmax, 16)); tmax = fmaxf(tmax, __shfl_xor(tmax, 32));
    const float mn = fmaxf(m, tmax), alpha = __expf(m - mn);
    m = mn;
    float ps = 0.f;
#pragma unroll
    for (int k4 = 0; k4 < 4; ++k4)
#pragma unroll
        for (int ii = 0; ii < 4; ++ii) { const float pv = (vmask & (1u << (k4 * 4 + ii))) ? __expf(st[k4][ii] - mn) : 0.f; st[k4][ii] = pv; ps += pv; }
    lsum = lsum * alpha + ps;
#pragma unroll
    for (int dt = 0; dt < 4; ++dt) o[dt] *= alpha;
}

DI void nsa_unit(const Params& p, int unit, float* imp, int* sel) {
    const int lane = threadIdx.x & 63, fr = lane & 15, fq = lane >> 4;
    const int qt = unit & 1023, kvh = (unit >> 10) & 1, b = unit >> 11;
    const int t0 = qt * 16, cur = t0 >> 6;
    const size_t n0 = (size_t)b * T_ + t0;
    const int bk = b * 2 + kvh;
    for (int i = lane; i < 16 * 260; i += 64) imp[i] = 0.f;
    __builtin_amdgcn_fence(__ATOMIC_SEQ_CST, "workgroup");
    f32x4 out[3][4];
#pragma unroll
    for (int g = 0; g < 3; ++g)
#pragma unroll
        for (int dt = 0; dt < 4; ++dt) out[g][dt] = (f32x4){0.f, 0.f, 0.f, 0.f};
    const bf16_t* gatep = p.proj + (n0 + fr) * DINP + C_GATE + kvh * 9;
    const int tq = t0 + fr;

    {
        const int nv = tq >= 31 ? ((tq - 31) >> 4) + 1 : 0;
        const int nvmax = t0 >= 16 ? (t0 >> 4) : 0;
        const int ntile = (nvmax + 63) >> 6;
        const bf16_t* KCp = p.kc + (size_t)bk * 1024 * 64;
        const bf16_t* VCp = p.vct + (size_t)bk * 16 * 4096;
#pragma unroll
        for (int g = 0; g < 3; ++g) {
            const int h = kvh * 3 + g;
            bf16x8 qf[2];
            qf[0] = *(const bf16x8*)(p.qn + ((n0 + fr) * 6 + h) * 64 + fq * 8);
            qf[1] = *(const bf16x8*)(p.qn + ((n0 + fr) * 6 + h) * 64 + 32 + fq * 8);
            float m = -1e30f, lsum = 0.f;
            f32x4 st[4], o[4];
#pragma unroll
            for (int dt = 0; dt < 4; ++dt) o[dt] = (f32x4){0.f, 0.f, 0.f, 0.f};
            for (int kt = 0; kt < ntile; ++kt) {
                st_tile(KCp + kt * 4096, qf, fr, fq, st);
                unsigned vm = 0;
#pragma unroll
                for (int k4 = 0; k4 < 4; ++k4)
#pragma unroll
                    for (int ii = 0; ii < 4; ++ii) if (kt * 64 + k4 * 16 + fq * 4 + ii < nv) vm |= 1u << (k4 * 4 + ii);
                online_step(st, vm, m, lsum, o);
            }
            lsum += __shfl_xor(lsum, 16); lsum += __shfl_xor(lsum, 32);
            const float inv = lsum > 0.f ? 1.f / lsum : 0.f;
            for (int kt = 0; kt < ntile; ++kt) {
                st_tile(KCp + kt * 4096, qf, fr, fq, st);
#pragma unroll
                for (int k4 = 0; k4 < 4; ++k4) {
                    float s4 = 0.f;
#pragma unroll
                    for (int ii = 0; ii < 4; ++ii) {
                        const float pv = (kt * 64 + k4 * 16 + fq * 4 + ii < nv) ? __expf(st[k4][ii] - m) * inv : 0.f;
                        st[k4][ii] = pv; s4 += pv;
                    }
                    const int j = kt * 16 + k4 * 4 + fq;
                    atomicAdd(&imp[fr * 260 + j], s4);
                    atomicAdd(&imp[fr * 260 + j + 1], st[k4][3]);
                }
                pv_tile(VCp + kt * 4096, st, fr, fq, o);
            }
            const float gate = sigmoidf_(bf2f(gatep[g * 3 + 0]));
#pragma unroll
            for (int dt = 0; dt < 4; ++dt) out[g][dt] = o[dt] * gate;
        }
    }
    __builtin_amdgcn_fence(__ATOMIC_SEQ_CST, "workgroup");

    {
        const int nforced = cur >= 2 ? 3 : cur + 1;
        const int need = 16 - nforced;
        const int ncand = cur >= 2 ? cur - 2 : 0;
#pragma unroll 1
        for (int qi = 0; qi < 16; ++qi) {
            if (lane < 16) {
                int v = -1;
                if (lane == 0) v = 0; else if (lane == 1 && cur >= 1) v = cur; else if (lane == 2 && cur >= 2) v = cur - 1;
                if (ncand <= need && lane >= nforced && lane - nforced < ncand) v = lane - nforced + 1;
                sel[qi * 16 + lane] = v;
            }
            if (ncand > need) {
                unsigned long long key[4];
#pragma unroll
                for (int r = 0; r < 4; ++r) {
                    const int j = lane + 64 * r;
                    key[r] = (j >= 1 && j <= cur - 2) ? (((unsigned long long)__float_as_uint(imp[qi * 260 + j]) << 32) | (unsigned)(1023 - j)) : 0ull;
                }
                for (int s = 0; s < need; ++s) {
                    unsigned long long best = key[0];
#pragma unroll
                    for (int r = 1; r < 4; ++r) best = key[r] > best ? key[r] : best;
#pragma unroll
                    for (int off = 32; off >= 1; off >>= 1) { const unsigned long long o2 = __shfl_xor(best, off); best = o2 > best ? o2 : best; }
                    const int jstar = 1023 - (int)(best & 0xffffffffull);
#pragma unroll
                    for (int r = 0; r < 4; ++r) if (lane + 64 * r == jstar) key[r] = 0ull;
                    if (lane == 0) sel[qi * 16 + nforced + s] = jstar;
                }
            }
        }
    }
    __builtin_amdgcn_fence(__ATOMIC_SEQ_CST, "workgroup");

    float* oacc = imp;
#pragma unroll
    for (int g = 0; g < 3; ++g)
#pragma unroll
        for (int dt = 0; dt < 4; ++dt) *(f32x4*)(oacc + (g * 16 + fr) * 64 + dt * 16 + fq * 4) = out[g][dt];
    __builtin_amdgcn_fence(__ATOMIC_SEQ_CST, "workgroup");
    {
        const bf16_t* KS = p.ksn + (size_t)bk * T_ * 64;
        const bf16_t* VS = p.vst + (size_t)bk * 256 * 4096;
#pragma unroll 1
        for (int qi = 0; qi < 16; ++qi) {
            const int t = t0 + qi;
            bf16x8 qf[2];
            const bf16x8 zero = (bf16x8){0, 0, 0, 0, 0, 0, 0, 0};
            const bf16_t* qp = p.qn + ((n0 + qi) * 6 + kvh * 3 + (fr < 3 ? fr : 0)) * 64 + fq * 8;
            qf[0] = *(const bf16x8*)qp; qf[1] = *(const bf16x8*)(qp + 32);
            if (fr >= 3) { qf[0] = zero; qf[1] = zero; }
            float m = -1e30f, lsum = 0.f;
            f32x4 st[4], o[4];
#pragma unroll
            for (int dt = 0; dt < 4; ++dt) o[dt] = (f32x4){0.f, 0.f, 0.f, 0.f};
            for (int s = 0; s < 16; ++s) {
                const int jb = __builtin_amdgcn_readfirstlane(sel[qi * 16 + s]);
                if (jb < 0) continue;
                st_tile(KS + (size_t)jb * 4096, qf, fr, fq, st);
                unsigned vm = 0;
#pragma unroll
                for (int k4 = 0; k4 < 4; ++k4)
#pragma unroll
                    for (int ii = 0; ii < 4; ++ii) if (jb * 64 + k4 * 16 + fq * 4 + ii <= t) vm |= 1u << (k4 * 4 + ii);
                online_step(st, vm, m, lsum, o);
                pv_tile(VS + (size_t)jb * 4096, st, fr, fq, o);
            }
            lsum += __shfl_xor(lsum, 16); lsum += __shfl_xor(lsum, 32);
            const float inv = lsum > 0.f ? 1.f / lsum : 0.f;
            if (fr < 3) {
                const float gate = sigmoidf_(bf2f(p.proj[(n0 + qi) * DINP + C_GATE + kvh * 9 + fr * 3 + 1])) * inv;
#pragma unroll
                for (int dt = 0; dt < 4; ++dt) {
                    float* a = oacc + (fr * 16 + qi) * 64 + dt * 16 + fq * 4;
                    *(f32x4*)a = *(const f32x4*)a + o[dt] * gate;
                }
            }
        }
        __builtin_amdgcn_fence(__ATOMIC_SEQ_CST, "workgroup");
    }

    {
        const bf16_t* KW = p.kwn + (size_t)bk * T_ * 64;
        const bf16_t* VW = p.vwt + (size_t)bk * 256 * 4096;
        const int lo = t0 - 511 > 0 ? t0 - 511 : 0;
        const int kb0 = lo >> 6, kb1 = t0 >> 6;
#pragma unroll 1
        for (int g = 0; g < 3; ++g) {
            const int h = kvh * 3 + g;
            bf16x8 qf[2];
            qf[0] = *(const bf16x8*)(p.qn + ((n0 + fr) * 6 + h) * 64 + fq * 8);
            qf[1] = *(const bf16x8*)(p.qn + ((n0 + fr) * 6 + h) * 64 + 32 + fq * 8);
            float m = -1e30f, lsum = 0.f;
            f32x4 st[4], o[4];
#pragma unroll
            for (int dt = 0; dt < 4; ++dt) o[dt] = (f32x4){0.f, 0.f, 0.f, 0.f};
            for (int kb = kb0; kb <= kb1; ++kb) {
                st_tile(KW + (size_t)kb * 4096, qf, fr, fq, st);
                unsigned vm = 0;
#pragma unroll
                for (int k4 = 0; k4 < 4; ++k4)
#pragma unroll
                    for (int ii = 0; ii < 4; ++ii) { const int kp = kb * 64 + k4 * 16 + fq * 4 + ii; if (kp <= tq && kp > tq - 512) vm |= 1u << (k4 * 4 + ii); }
                online_step(st, vm, m, lsum, o);
                pv_tile(VW + (size_t)kb * 4096, st, fr, fq, o);
            }
            lsum += __shfl_xor(lsum, 16); lsum += __shfl_xor(lsum, 32);
            const float inv = lsum > 0.f ? 1.f / lsum : 0.f;
            const float gate = sigmoidf_(bf2f(gatep[g * 3 + 2])) * inv;
#pragma unroll
            for (int dt = 0; dt < 4; ++dt) {
                const f32x4 r = *(const f32x4*)(oacc + (g * 16 + fr) * 64 + dt * 16 + fq * 4) + o[dt] * gate;
                u32x2 o2; o2[0] = pk2(r[0], r[1]); o2[1] = pk2(r[2], r[3]);
                *(u32x2*)(p.hy + (n0 + fr) * DM + 384 + h * 64 + dt * 16 + fq * 4) = o2;
            }
        }
    }
    __builtin_amdgcn_fence(__ATOMIC_SEQ_CST, "workgroup");
}

DI void phase_nsa(const Params& p, int wave_id, int wave_stride, char* smem) {
    const int wave = threadIdx.x >> 6;
    float* imp = (float*)(smem + wave * 17664);
    int* sel = (int*)(smem + wave * 17664 + 16640);
    for (int unit = wave_id; unit < 4096; unit += wave_stride) {
        const int u2 = (unit & ~1023) | (1023 - (unit & 1023));
        nsa_unit(p, u2, imp, sel);
    }
}

DI void run_phase(const Params& p, int ph, int l, char* smem) {
    const float* xin = (l == 0) ? p.x : p.out;
    switch (ph) {
    case 0: phase_convert(p, smem); break;
    case 1: phase_rmsnorm(xin, p.norm_mix + l * DM, p.hy); break;
    case 2: gemm_phase<0>(p.hy, p.wb_in + (size_t)l * DINP * DM, NTOK, DINP, DM, p.proj, p.side, nullptr, nullptr, smem); break;
    case 3:
        phase_gdn_prep(p, l, smem);
        phase_nsa_prep(p, l, smem);
        phase_compress(p, l, blockIdx.x * 4 + (threadIdx.x >> 6), gridDim.x * 4);
        phase_pool(p, l, smem);
        break;
    case 4:
        if (gridDim.x > 4 * NSCAN) {
            if (blockIdx.x < NSCAN) gdn_scan_block(p, blockIdx.x, smem);
            else phase_nsa(p, (blockIdx.x - NSCAN) * 4 + (threadIdx.x >> 6), (gridDim.x - NSCAN) * 4, smem);
        } else {
            for (int bh = blockIdx.x; bh < NSCAN; bh += gridDim.x) gdn_scan_block(p, bh, smem);
            phase_nsa(p, blockIdx.x * 4 + (threadIdx.x >> 6), gridDim.x * 4, smem);
        }
        break;
    case 5: phase_gdn_final(p, l); break;
    case 6: gemm_phase<2>(p.hy, p.wb_out + (size_t)l * DM * DM, NTOK, DM, DM, nullptr, nullptr, xin, p.out, smem); break;
    case 7: phase_rmsnorm(p.out, p.norm_ffn + l * DM, p.hy); break;
    case 8: gemm_phase<1>(p.hy, p.wb_f1 + (size_t)l * DFF * DM, NTOK, DFF, DM, p.hid, nullptr, nullptr, nullptr, smem); break;
    case 9: gemm_phase<2>(p.hid, p.wb_f2 + (size_t)l * DM * DFF, NTOK, DM, DFF, nullptr, nullptr, p.out, p.out, smem); break;
    }
}

#if MEGA
__global__ void __launch_bounds__(256, 2) mega_kernel(Params p) {
    extern __shared__ __attribute__((aligned(16))) char smem[];
    cg::grid_group grid = cg::this_grid();
    run_phase(p, 0, 0, smem);
    grid.sync();
    for (int l = 0; l < 2; ++l) {
#pragma unroll 1
        for (int ph = 1; ph <= 9; ++ph) {
            run_phase(p, ph, l, smem);
            grid.sync();
        }
    }
}
#else
template <int PH>
__global__ void __launch_bounds__(256, 2) phase_kernel(Params p, int l) {
    extern __shared__ __attribute__((aligned(16))) char smem[];
    run_phase(p, PH, l, smem);
}
#endif

extern "C" void kernel_launch(void* const* d_in, const int* in_sizes, int n_in, void* d_out, int out_size, void* d_ws, size_t ws_size,
                              hipStream_t stream) {
    Params p{};
    p.x = (const float*)d_in[0]; p.norm_mix = (const float*)d_in[1]; p.w_in = (const float*)d_in[2]; p.conv_w = (const float*)d_in[3];
    p.a_log = (const float*)d_in[4]; p.dt_bias = (const float*)d_in[5]; p.gdn_norm = (const float*)d_in[6]; p.q_norm = (const float*)d_in[7];
    p.k_norm = (const float*)d_in[8]; p.cmp_pos = (const float*)d_in[9]; p.cmp_w1 = (const float*)d_in[10]; p.cmp_w2 = (const float*)d_in[11];
    p.pool_w = (const float*)d_in[12]; p.pool_scale = (const float*)d_in[13]; p.w_out = (const float*)d_in[14]; p.norm_ffn = (const float*)d_in[15];
    p.w_ffn1 = (const float*)d_in[16]; p.w_ffn2 = (const float*)d_in[17];
    p.out = (float*)d_out;
    char* ws = (char*)d_ws; size_t off = 0;
    auto take = [&](size_t bytes) { char* r = ws + off; off += (bytes + 255) & ~(size_t)255; return r; };
    p.wb_in = (bf16_t*)take((size_t)2 * DINP * DM * 2);
    p.wb_out = (bf16_t*)take((size_t)2 * DM * DM * 2);
    p.wb_f1 = (bf16_t*)take((size_t)2 * DFF * DM * 2);
    p.wb_f2 = (bf16_t*)take((size_t)2 * DFF * DM * 2);
    p.wb_c1 = (bf16_t*)take((size_t)4 * 256 * 2048 * 2);
    p.wb_c2 = (bf16_t*)take((size_t)4 * 64 * 256 * 2);
    p.hy = (bf16_t*)take((size_t)NTOK * DM * 2);
    p.proj = (bf16_t*)take((size_t)NTOK * DINP * 2);
    p.hid = p.proj;
    p.rec = take((size_t)3072 * REC);
    p.glast = (float*)take(3072 * 4);
    p.side = (float*)take((size_t)NTOK * 12 * 4);
    p.qn = (bf16_t*)take((size_t)NTOK * 384 * 2);
    p.ksn = (bf16_t*)take((size_t)NTOK * 128 * 2);
    p.kwn = (bf16_t*)take((size_t)NTOK * 128 * 2);
    p.vst = (bf16_t*)take((size_t)NTOK * 128 * 2);
    p.vwt = (bf16_t*)take((size_t)NTOK * 128 * 2);
    p.kc = (bf16_t*)take((size_t)4 * 1024 * 64 * 2);
    p.vct = (bf16_t*)take((size_t)4 * 16 * 4096 * 2);
    if (off > ws_size) { fprintf(stderr, "workspace too small: need %zu have %zu\n", off, ws_size); return; }
#if MEGA
    hipFuncSetAttribute((const void*)mega_kernel, hipFuncAttributeMaxDynamicSharedMemorySize, LDS_BYTES);
    int dev = 0, cus = 0, per_cu = 0;
    hipGetDevice(&dev);
    hipDeviceGetAttribute(&cus, hipDeviceAttributeMultiprocessorCount, dev);
    hipOccupancyMaxActiveBlocksPerMultiprocessor(&per_cu, mega_kernel, 256, LDS_BYTES);
    if (per_cu > 2) per_cu = 2;
    int grid = cus * per_cu;
    void* args[] = {&p};
    hipError_t e = hipLaunchCooperativeKernel((void*)mega_kernel, dim3(grid), dim3(256), args, LDS_BYTES, stream);
    if (e != hipSuccess) fprintf(stderr, "cooperative launch failed: %s (grid %d)\n", hipGetErrorString(e), grid);
#else
    const int G = 512;
#define LAUNCH(PH, GRID, L) do { hipFuncSetAttribute((const void*)phase_kernel<PH>, hipFuncAttributeMaxDynamicSharedMemorySize, LDS_BYTES); \
        phase_kernel<PH><<<GRID, 256, LDS_BYTES, stream>>>(p, L); } while (0)
    LAUNCH(0, G, 0);
    for (int l = 0; l < 2; ++l) {
        LAUNCH(1, G, l); LAUNCH(2, G, l); LAUNCH(3, G, l); LAUNCH(4, G, l); LAUNCH(5, G, l);
        LAUNCH(6, G, l); LAUNCH(7, G, l); LAUNCH(8, G, l); LAUNCH(9, G, l);
    }
#endif
}
```

```cpp
#include <hip/hip_runtime.h>
#include <hip/hip_cooperative_groups.h>
#include <cstdio>
#include <cstdint>
namespace cg = cooperative_groups;

#ifndef MEGA
#define MEGA 1
#endif

typedef unsigned short bf16_t;
typedef short bf16x8 __attribute__((ext_vector_type(8)));
typedef float f32x4 __attribute__((ext_vector_type(4)));
typedef unsigned u32x4 __attribute__((ext_vector_type(4)));
typedef unsigned u32x2 __attribute__((ext_vector_type(2)));
#define DI __device__ __forceinline__

constexpr int T_ = 16384, NB = 2, NTOK = 32768, DM = 1024, DINO = 2974, DINP = 3072, DFF = 4096;
constexpr int C_QKV = 0, C_Z = 1152, C_BA = 1536, C_QB = 1600, C_KV = 1984, C_GATE = 2752, C_UC = 2816;
constexpr int LDS_BYTES = 73728;
constexpr int REC = 40960;
constexpr int NSCAN = 12;

struct Params {
    const float* x; const float* norm_mix; const float* w_in; const float* conv_w; const float* a_log; const float* dt_bias;
    const float* gdn_norm; const float* q_norm; const float* k_norm; const float* cmp_pos; const float* cmp_w1; const float* cmp_w2;
    const float* pool_w; const float* pool_scale; const float* w_out; const float* norm_ffn; const float* w_ffn1; const float* w_ffn2;
    float* out;
    bf16_t* wb_in; bf16_t* wb_out; bf16_t* wb_f1; bf16_t* wb_f2; bf16_t* wb_c1; bf16_t* wb_c2;
    bf16_t* hy;
    bf16_t* proj;
    bf16_t* hid;
    char* rec;
    float* glast;
    float* side;
    bf16_t* qn;
    bf16_t* ksn; bf16_t* kwn;
    bf16_t* vst; bf16_t* vwt;
    bf16_t* kc;
    bf16_t* vct;
    unsigned* bar;
    bf16_t* h2;
    float* ssq;
    int* nsa_ctr;
};

DI int tid_() { int t = threadIdx.x; asm volatile("" : "+v"(t)); return t; }
DI float bf2f(bf16_t v) { return __uint_as_float(((unsigned)v) << 16); }
DI bf16_t f2bf(float x) { unsigned u = __float_as_uint(x); u += 0x7fffu + ((u >> 16) & 1u); return (bf16_t)(u >> 16); }
typedef __bf16 bf16x2_t __attribute__((ext_vector_type(2)));
typedef float f32x2 __attribute__((ext_vector_type(2)));
DI unsigned pk2(float lo, float hi) { f32x2 v = {lo, hi}; bf16x2_t r = __builtin_convertvector(v, bf16x2_t); return __builtin_bit_cast(unsigned, r); }
DI f32x4 mfma(bf16x8 a, bf16x8 b, f32x4 c) { return __builtin_amdgcn_mfma_f32_16x16x32_bf16(a, b, c, 0, 0, 0); }
DI bf16x8 pack2(f32x4 a, f32x4 b) {
    u32x4 r; r[0] = pk2(a[0], a[1]); r[1] = pk2(a[2], a[3]); r[2] = pk2(b[0], b[1]); r[3] = pk2(b[2], b[3]);
    return __builtin_bit_cast(bf16x8, r);
}
DI int PERM(int p) { return (p & ~31) + 16 * ((p >> 2) & 1) + 4 * ((p >> 3) & 3) + (p & 3); }
DI int PINV(int s) { return (s & ~31) | ((s & 12) << 1) | ((s & 16) >> 2) | (s & 3); }
DI float sigmoidf_(float x) { return 1.f / (1.f + __expf(-x)); }
DI float siluf_(float x) { return x / (1.f + __expf(-x)); }

DI void cvt_job(const float* src, bf16_t* dst, int K, int Nn, int NnPad, int remap, char* smem) {
    float* tile = (float*)smem;
    const int tid = tid_();
    const int nkt = K / 64, items = nkt * (NnPad / 64);
    for (int it = blockIdx.x; it < items; it += gridDim.x) {
        const int kt = it % nkt, nt = it / nkt;
        {
            const int c = tid & 63, r = tid >> 6;
            const int nn = nt * 64 + c;
            int no = nn;
            if (remap) { no = nn < 1548 ? nn : (nn < 1600 ? -1 : (nn < 2770 ? nn - 52 : (nn < 2816 ? -1 : nn - 98))); }
            if (no >= Nn) no = -1;
#pragma unroll
            for (int i = 0; i < 16; ++i) {
                const int k = r + 4 * i;
                tile[k * 65 + c] = (no >= 0) ? src[(size_t)(kt * 64 + k) * Nn + no] : 0.f;
            }
        }
        __syncthreads();
        {
            const int nl = tid >> 2, part = tid & 3;
            u32x4 v0, v1;
#pragma unroll
            for (int j = 0; j < 4; ++j) {
                v0[j] = pk2(tile[(part * 16 + 2 * j) * 65 + nl], tile[(part * 16 + 2 * j + 1) * 65 + nl]);
                v1[j] = pk2(tile[(part * 16 + 8 + 2 * j) * 65 + nl], tile[(part * 16 + 8 + 2 * j + 1) * 65 + nl]);
            }
            bf16_t* d = dst + (size_t)(nt * 64 + nl) * K + kt * 64 + part * 16;
            *(u32x4*)d = v0; *(u32x4*)(d + 8) = v1;
        }
        __syncthreads();
    }
}
DI void phase_convert(const Params& p, char* smem) {
    for (int i = blockIdx.x * 256 + tid_(); i < 3 * NTOK; i += gridDim.x * 256) p.ssq[i] = 0.f;
    if (blockIdx.x == 0 && tid_() < 8) p.nsa_ctr[tid_()] = 0;
    for (int l = 0; l < 2; ++l) {
        cvt_job(p.w_in + (size_t)l * DM * DINO, p.wb_in + (size_t)l * DINP * DM, DM, DINO, DINP, 1, smem);
        cvt_job(p.w_out + (size_t)l * DM * DM, p.wb_out + (size_t)l * DM * DM, DM, DM, DM, 0, smem);
        cvt_job(p.w_ffn1 + (size_t)l * DM * DFF, p.wb_f1 + (size_t)l * DFF * DM, DM, DFF, DFF, 0, smem);
        cvt_job(p.w_ffn2 + (size_t)l * DFF * DM, p.wb_f2 + (size_t)l * DM * DFF, DFF, DM, DM, 0, smem);
        for (int kv = 0; kv < 2; ++kv) {
            cvt_job(p.cmp_w1 + (size_t)(l * 2 + kv) * 2048 * 256, p.wb_c1 + (size_t)(l * 2 + kv) * 256 * 2048, 2048, 256, 256, 0, smem);
            cvt_job(p.cmp_w2 + (size_t)(l * 2 + kv) * 256 * 64, p.wb_c2 + (size_t)(l * 2 + kv) * 64 * 256, 256, 64, 64, 0, smem);
        }
    }
}

DI void phase_rmsnorm(const float* X, const float* g, bf16_t* H) {
    const int lane = tid_() & 63, wave = __builtin_amdgcn_readfirstlane(tid_() >> 6);
    for (int row = blockIdx.x * 4 + wave; row < NTOK; row += gridDim.x * 4) {
        const float* xr = X + (size_t)row * DM;
        f32x4 v[4]; float ss = 0.f;
#pragma unroll
        for (int i = 0; i < 4; ++i) { v[i] = *(const f32x4*)(xr + i * 256 + lane * 4); ss += v[i][0] * v[i][0] + v[i][1] * v[i][1] + v[i][2] * v[i][2] + v[i][3] * v[i][3]; }
#pragma unroll
        for (int o = 32; o >= 1; o >>= 1) ss += __shfl_xor(ss, o);
        const float r = rsqrtf(ss * (1.f / DM) + 1e-6f);
#pragma unroll
        for (int i = 0; i < 4; ++i) {
            const f32x4 gg = *(const f32x4*)(g + i * 256 + lane * 4);
            u32x2 o2; o2[0] = pk2(v[i][0] * r * gg[0], v[i][1] * r * gg[1]); o2[1] = pk2(v[i][2] * r * gg[2], v[i][3] * r * gg[3]);
            *(u32x2*)(H + (size_t)row * DM + i * 256 + lane * 4) = o2;
        }
    }
}

template <int EPI>
DI void gemm_phase(const bf16_t* __restrict__ A, const bf16_t* __restrict__ Bt, int M, int Nn, int K,
                   bf16_t* outb, float* side, const float* xin, float* xout, char* smem,
                   const float* rs_in = nullptr, bf16_t* hb = nullptr, const float* gn = nullptr, float* ssq_out = nullptr) {
    const int tid = tid_(), lane = tid & 63, wave = tid >> 6, wr = wave >> 1, wc = wave & 1, fr = lane & 15, fq = lane >> 4;
    const int nNt = Nn / 256, nTiles = (M / 128) * nNt, nk = K / 32;
    bf16_t* sA = (bf16_t*)smem;
    bf16_t* sB = sA + 2 * 128 * 40;
    const int lrow = tid >> 2, lcc = tid & 3;
    const int xcd = blockIdx.x & 7, nbx = gridDim.x >> 3, nNb = nNt >> 2, perX = (nTiles >> 3);
    auto tile_of = [&](int idx, int& mt_, int& nt_) { const int q = idx >> 6, r = idx & 63; mt_ = ((q / nNb) * 16 + (r >> 2)) * 8 + xcd; nt_ = (q % nNb) * 4 + (r & 3); };
    u32x4 ra[2], rb[4];
#define G_LOAD(PA, PB, STEP) do { _Pragma("unroll") for (int i_ = 0; i_ < 2; ++i_) ra[i_] = *(const u32x4*)((PA) + (size_t)(64 * i_) * K + (STEP) * 32); \
        _Pragma("unroll") for (int i_ = 0; i_ < 4; ++i_) rb[i_] = *(const u32x4*)((PB) + (size_t)(64 * i_) * K + (STEP) * 32); } while (0)
#define G_STORE(BUF) do { _Pragma("unroll") for (int i_ = 0; i_ < 2; ++i_) *(u32x4*)(sA + (BUF) * 128 * 40 + (lrow + 64 * i_) * 40 + lcc * 8) = ra[i_]; \
        _Pragma("unroll") for (int i_ = 0; i_ < 4; ++i_) *(u32x4*)(sB + (BUF) * 256 * 40 + (lrow + 64 * i_) * 40 + lcc * 8) = rb[i_]; } while (0)
    const int idx0 = blockIdx.x >> 3;
    if (idx0 < perX) {
        int mt0, nt0; tile_of(idx0, mt0, nt0);
        const bf16_t* A0 = A + (size_t)(mt0 * 128 + lrow) * K + lcc * 8;
        const bf16_t* B0 = Bt + (size_t)(nt0 * 256 + lrow) * K + lcc * 8;
        G_LOAD(A0, B0, 0);
        G_STORE(0);
        G_LOAD(A0, B0, 1);
        __syncthreads();
    }
    for (int idx = idx0; idx < perX; idx += nbx) {
        int mt, nt; tile_of(idx, mt, nt);
        int mtn, ntn; tile_of(idx + nbx < perX ? idx + nbx : idx, mtn, ntn);
        const bf16_t* Ag = A + (size_t)(mt * 128 + lrow) * K + lcc * 8;
        const bf16_t* Bg = Bt + (size_t)(nt * 256 + lrow) * K + lcc * 8;
        const bf16_t* An = A + (size_t)(mtn * 128 + lrow) * K + lcc * 8;
        const bf16_t* Bn = Bt + (size_t)(ntn * 256 + lrow) * K + lcc * 8;
        f32x4 acc[4][8];
#pragma unroll
        for (int i = 0; i < 4; ++i)
#pragma unroll
            for (int j = 0; j < 8; ++j) {
                if (EPI == 2)
                    acc[i][j] = *(const f32x4*)(xin + (size_t)(mt * 128 + wr * 64 + i * 16 + fr) * Nn + nt * 256 + wc * 128 + j * 16 + fq * 4);
                else acc[i][j] = (f32x4){0.f, 0.f, 0.f, 0.f};
            }
        for (int kt = 0; kt < nk; ++kt) {
            const int buf = kt & 1;
            const bf16_t* a_ = sA + buf * 128 * 40 + (wr * 64 + fr) * 40 + fq * 8;
            const bf16_t* b_ = sB + buf * 256 * 40 + (wc * 128 + fr) * 40 + fq * 8;
            bf16x8 af[4];
#pragma unroll
            for (int i = 0; i < 4; ++i) af[i] = *(const bf16x8*)(a_ + i * 16 * 40);
#pragma unroll
            for (int jh = 0; jh < 2; ++jh) {
                bf16x8 bfr[4];
#pragma unroll
                for (int j = 0; j < 4; ++j) bfr[j] = *(const bf16x8*)(b_ + (jh * 4 + j) * 16 * 40);
#pragma unroll
                for (int i = 0; i < 4; ++i)
#pragma unroll
                    for (int j = 0; j < 4; ++j) acc[i][jh * 4 + j] = mfma(bfr[j], af[i], acc[i][jh * 4 + j]);
            }
            G_STORE(buf ^ 1);
            {
                const bool cur = kt + 2 < nk;
                const bf16_t* pa = cur ? Ag : An; const bf16_t* pb = cur ? Bg : Bn;
                const int st = cur ? kt + 2 : kt + 2 - nk;
                G_LOAD(pa, pb, st);
            }
            __syncthreads();
        }
#undef G_LOAD
#undef G_STORE
#pragma unroll
        for (int i = 0; i < 4; ++i) {
            const int m = mt * 128 + wr * 64 + i * 16 + fr;
            float rsc = 1.f;
            if (EPI != 2 && rs_in) rsc = rsqrtf(rs_in[m] * (1.f / DM) + 1e-6f);
            float sq = 0.f;
#pragma unroll
            for (int j = 0; j < 8; ++j) {
                const int n = nt * 256 + wc * 128 + j * 16 + fq * 4;
                f32x4 v = acc[i][j] * rsc;
                if (EPI == 0) {
                    u32x2 o2; o2[0] = pk2(v[0], v[1]); o2[1] = pk2(v[2], v[3]);
                    *(u32x2*)(outb + (size_t)m * Nn + n) = o2;
                    if (n >= C_BA && n < C_BA + 12) *(f32x4*)(side + (size_t)m * 12 + (n - C_BA)) = v;
                } else if (EPI == 1) {
#pragma unroll
                    for (int e = 0; e < 4; ++e) { const float r2 = fmaxf(v[e], 0.f); v[e] = r2 * r2; }
                    u32x2 o2; o2[0] = pk2(v[0], v[1]); o2[1] = pk2(v[2], v[3]);
                    *(u32x2*)(outb + (size_t)m * Nn + n) = o2;
                } else {
                    const f32x4 xn = v;
                    *(f32x4*)(xout + (size_t)m * Nn + n) = xn;
                    if (hb) {
                        const f32x4 g4 = *(const f32x4*)(gn + n);
                        u32x2 o2; o2[0] = pk2(xn[0] * g4[0], xn[1] * g4[1]); o2[1] = pk2(xn[2] * g4[2], xn[3] * g4[3]);
                        *(u32x2*)(hb + (size_t)m * Nn + n) = o2;
                        sq += xn[0] * xn[0] + xn[1] * xn[1] + xn[2] * xn[2] + xn[3] * xn[3];
                    }
                }
            }
            if (EPI == 2 && hb) {
                sq += __shfl_xor(sq, 16); sq += __shfl_xor(sq, 32);
                if (fq == 0) atomicAdd(ssq_out + m, sq);
            }
        }
    }
}

DI void phase_gdn_prep(const Params& p, int l, char* smem) {
    float* sq = (float*)smem; float* sk = sq + 64 * 65; float* sv = sk + 64 * 65; float* sL = sv + 64 * 65;
    float* sgc = sL + 64 * 64; float* sbeta = sgc + 64;
    const int tid = tid_(), lane = tid & 63;
    const float* cw = p.conv_w + (size_t)l * 4 * 1152;
    u32x4 raw[9]; float pbb = 0.f, paa = 0.f;
    auto prefetch = [&](int it) {
        const int chunk_ = it & 255, bh_ = it >> 8, h_ = bh_ % 6, b_ = bh_ / 6;
        const int tb0_ = chunk_ * 64; const size_t row0_ = (size_t)b_ * T_ + tb0_;
#pragma unroll
        for (int part = 0; part < 3; ++part)
#pragma unroll
            for (int k = 0; k < 3; ++k) {
                const int c = tid + 256 * k, r = c >> 3, cc = c & 7;
                const bool ok = c < 67 * 8 && tb0_ + r - 3 >= 0;
                const bf16_t* src = p.proj + (row0_ + (ok ? r : 3) - 3) * DINP + part * 384 + h_ * 64 + cc * 8;
                const u32x4 v = *(const u32x4*)src;
                raw[part * 3 + k] = ok ? v : (u32x4){0u, 0u, 0u, 0u};
            }
        if (tid < 64) { pbb = p.side[(row0_ + tid) * 12 + h_]; paa = p.side[(row0_ + tid) * 12 + 6 + h_]; }
    };
    if ((int)blockIdx.x < 3072) prefetch(blockIdx.x);
    for (int item = blockIdx.x; item < 3072; item += gridDim.x) {
        const int chunk = item & 255, bh = item >> 8, h = bh % 6, b = bh / 6;
        const int tb0 = chunk * 64; const size_t row0 = (size_t)b * T_ + tb0;
        char* rec = p.rec + (size_t)item * REC;
        {
            bf16_t* sraw = (bf16_t*)sL;
            const int ch = tid & 63, tq = tid >> 6;
#pragma unroll
            for (int part = 0; part < 3; ++part) {
#pragma unroll
                for (int k = 0; k < 3; ++k) { const int c = tid + 256 * k; if (c < 67 * 8) *(u32x4*)(sraw + c * 8) = raw[part * 3 + k]; }
                __syncthreads();
                const int col = part * 384 + h * 64 + ch;
                const float w0 = cw[col], w1 = cw[1152 + col], w2 = cw[2 * 1152 + col], w3 = cw[3 * 1152 + col];
                float* dst = part == 0 ? sq : (part == 1 ? sk : sv);
#pragma unroll
                for (int i = 0; i < 16; ++i) {
                    const int t = tq + 4 * i;
                    const float x0 = bf2f(sraw[(t + 0) * 64 + ch]), x1 = bf2f(sraw[(t + 1) * 64 + ch]);
                    const float x2 = bf2f(sraw[(t + 2) * 64 + ch]), x3 = bf2f(sraw[(t + 3) * 64 + ch]);
                    const float a = x0 * w0 + x1 * w1 + x2 * w2 + x3 * w3;
                    dst[t * 65 + ch] = siluf_(a);
                }
                __syncthreads();
            }
        }
        const float bb = pbb, aa = paa;
        if (tid < 64) {
            const float xx = aa + p.dt_bias[l * 6 + h];
            const float sp = xx > 20.f ? xx : log1pf(expf(xx));
            float g = -expf(p.a_log[l * 6 + h]) * sp;
#pragma unroll
            for (int off = 1; off < 64; off <<= 1) { const float v = __shfl_up(g, off); if (lane >= off) g += v; }
            sgc[tid] = g; sbeta[tid] = 1.f / (1.f + expf(-bb));
            if (tid == 63) p.glast[item] = expf(g);
        }
        __syncthreads();
        {
            const int t = tid >> 2, part = tid & 3;
            float s1 = 0.f, s2 = 0.f;
#pragma unroll
            for (int j = 0; j < 16; ++j) { const float a = sq[t * 65 + part * 16 + j], c = sk[t * 65 + part * 16 + j]; s1 += a * a; s2 += c * c; }
            s1 += __shfl_xor(s1, 1); s1 += __shfl_xor(s1, 2); s2 += __shfl_xor(s2, 1); s2 += __shfl_xor(s2, 2);
            const float r1 = rsqrtf(s1 + 1e-6f) * 0.125f, r2 = rsqrtf(s2 + 1e-6f);
#pragma unroll
            for (int j = 0; j < 16; ++j) { sq[t * 65 + part * 16 + j] *= r1; sk[t * 65 + part * 16 + j] *= r2; }
        }
        __syncthreads();
        f32x4 kkt[4], qkt[4];
        {
            char* qb = (char*)sL; char* kb = qb + 8192;
            {
                const int t = tid >> 2, part = tid & 3, sw = (t >> 1) & 7;
                u32x4 a0, a1, c0, c1;
#pragma unroll
                for (int j = 0; j < 4; ++j) {
                    a0[j] = pk2(sq[t * 65 + part * 16 + 2 * j], sq[t * 65 + part * 16 + 2 * j + 1]); a1[j] = pk2(sq[t * 65 + part * 16 + 8 + 2 * j], sq[t * 65 + part * 16 + 9 + 2 * j]);
                    c0[j] = pk2(sk[t * 65 + part * 16 + 2 * j], sk[t * 65 + part * 16 + 2 * j + 1]); c1[j] = pk2(sk[t * 65 + part * 16 + 8 + 2 * j], sk[t * 65 + part * 16 + 9 + 2 * j]);
                }
                *(u32x4*)(qb + t * 128 + (((part * 2) ^ sw) << 4)) = a0; *(u32x4*)(qb + t * 128 + (((part * 2 + 1) ^ sw) << 4)) = a1;
                *(u32x4*)(kb + t * 128 + (((part * 2) ^ sw) << 4)) = c0; *(u32x4*)(kb + t * 128 + (((part * 2 + 1) ^ sw) << 4)) = c1;
            }
            __syncthreads();
            const int wv = tid >> 6, fr = lane & 15, fq = lane >> 4;
            const int rc = wv * 16 + fr, swc = (rc >> 1) & 7;
            bf16x8 kB[2], qB[2];
#pragma unroll
            for (int ks = 0; ks < 2; ++ks) {
                kB[ks] = *(const bf16x8*)(kb + rc * 128 + (((ks * 4 + fq) ^ swc) << 4));
                qB[ks] = *(const bf16x8*)(qb + rc * 128 + (((ks * 4 + fq) ^ swc) << 4));
            }
#pragma unroll
            for (int st = 0; st < 4; ++st) {
                const int rs = st * 16 + fr, sws = (rs >> 1) & 7;
                const bf16x8 kA0 = *(const bf16x8*)(kb + rs * 128 + (((0 + fq) ^ sws) << 4)), kA1 = *(const bf16x8*)(kb + rs * 128 + (((4 + fq) ^ sws) << 4));
                f32x4 z = (f32x4){0.f, 0.f, 0.f, 0.f};
                kkt[st] = mfma(kA1, kB[1], mfma(kA0, kB[0], z));
                qkt[st] = mfma(kA1, qB[1], mfma(kA0, qB[0], z));
            }
        }
        {
            const int r = tid >> 2, part = tid & 3;
            const float eg = __expf(sgc[r]);
            u32x4 v0, v1, w0, w1;
#pragma unroll
            for (int j = 0; j < 8; ++j) {
                const int p0 = part * 16 + 2 * j, p1 = p0 + 1;
                const unsigned a = pk2(sq[r * 65 + PERM(p0)] * eg, sq[r * 65 + PERM(p1)] * eg);
                const int c0 = PERM(p0), c1 = PERM(p1);
                const unsigned c = pk2(sk[c0 * 65 + r] * __expf(sgc[63] - sgc[c0]), sk[c1 * 65 + r] * __expf(sgc[63] - sgc[c1]));
                if (j < 4) { v0[j] = a; w0[j] = c; } else { v1[j - 4] = a; w1[j - 4] = c; }
            }
            *(u32x4*)(rec + 8192 + (r * 64 + part * 16) * 2) = v0; *(u32x4*)(rec + 8192 + (r * 64 + part * 16 + 8) * 2) = v1;
            *(u32x4*)(rec + 24576 + (r * 64 + part * 16) * 2) = w0; *(u32x4*)(rec + 24576 + (r * 64 + part * 16 + 8) * 2) = w1;
        }
        __syncthreads();
        {
            const int wv = tid >> 6, fr = lane & 15, fq = lane >> 4;
            const int c = wv * 16 + fr;
            const float gcc = sgc[c], bc = sbeta[c];
#pragma unroll
            for (int st = 0; st < 4; ++st) {
                const int s0 = st * 16 + fq * 4;
                f32x4 lv; float qv[4];
#pragma unroll
                for (int ii = 0; ii < 4; ++ii) {
                    const int s_ = s0 + ii;
                    const float e = (s_ <= c) ? __expf(gcc - sgc[s_]) : 0.f;
                    lv[ii] = (s_ < c) ? bc * kkt[st][ii] * e : 0.f;
                    qv[ii] = qkt[st][ii] * e;
                }
                *(f32x4*)(sL + c * 64 + s0) = lv;
                u32x2 o2; o2[0] = pk2(qv[0], qv[1]); o2[1] = pk2(qv[2], qv[3]);
                *(u32x2*)(rec + 16384 + (c * 64 + PINV(s0)) * 2) = o2;
            }
        }
        {
            const int t = tid >> 2, part = tid & 3;
            const float bt = sbeta[t], be = bt * __expf(sgc[t]);
#pragma unroll
            for (int j = 0; j < 16; ++j) { sv[t * 65 + part * 16 + j] *= bt; sk[t * 65 + part * 16 + j] *= be; }
        }
        __syncthreads();
        { const int nxt = item + (int)gridDim.x; prefetch(nxt < 3072 ? nxt : item); }
        for (int rb = 0; rb < 4; ++rb) {
            if (rb > 0) {
                const int j = tid & 127, rh = tid >> 7;
                float* X = (j < 64) ? sv : sk; const int col = j & 63;
                const int r0 = rb * 16 + rh * 8;
                float a[8];
#pragma unroll
                for (int i = 0; i < 8; ++i) a[i] = 0.f;
                for (int s4 = 0; s4 < rb * 16; s4 += 4) {
                    const float x0 = X[(s4 + 0) * 65 + col], x1 = X[(s4 + 1) * 65 + col], x2 = X[(s4 + 2) * 65 + col], x3 = X[(s4 + 3) * 65 + col];
#pragma unroll
                    for (int i = 0; i < 8; ++i) {
                        const f32x4 lv = *(const f32x4*)(sL + (r0 + i) * 64 + s4);
                        a[i] += lv[0] * x0 + lv[1] * x1 + lv[2] * x2 + lv[3] * x3;
                    }
                }
#pragma unroll
                for (int i = 0; i < 8; ++i) X[(r0 + i) * 65 + col] -= a[i];
                __syncthreads();
            }
            if (tid < 128) {
                float* X = (tid < 64) ? sv : sk; const int col = tid & 63;
                float x[16];
#pragma unroll
                for (int i = 0; i < 16; ++i) x[i] = X[(rb * 16 + i) * 65 + col];
#pragma unroll
                for (int i = 1; i < 16; ++i) {
                    const float* Lr = sL + (rb * 16 + i) * 64 + rb * 16;
                    float acc = x[i];
#pragma unroll
                    for (int s2 = 0; s2 < i; ++s2) acc -= Lr[s2] * x[s2];
                    x[i] = acc;
                }
#pragma unroll
                for (int i = 1; i < 16; ++i) X[(rb * 16 + i) * 65 + col] = x[i];
            }
            __syncthreads();
        }
        {
            const int r = tid >> 2, part = tid & 3;
            u32x4 v0, v1, w0, w1;
#pragma unroll
            for (int j = 0; j < 8; ++j) {
                const int p0 = part * 16 + 2 * j, p1 = p0 + 1;
                const unsigned a = pk2(sk[r * 65 + PERM(p0)], sk[r * 65 + PERM(p1)]);
                const unsigned c = pk2(sv[p0 * 65 + r], sv[p1 * 65 + r]);
                if (j < 4) { v0[j] = a; w0[j] = c; } else { v1[j - 4] = a; w1[j - 4] = c; }
            }
            *(u32x4*)(rec + (r * 64 + part * 16) * 2) = v0; *(u32x4*)(rec + (r * 64 + part * 16 + 8) * 2) = v1;
            *(u32x4*)(rec + 32768 + (r * 64 + part * 16) * 2) = w0; *(u32x4*)(rec + 32768 + (r * 64 + part * 16 + 8) * 2) = w1;
        }
        __syncthreads();
    }
}

DI void gdn_scan_block(const Params& p, int bh, char* smem) {
    __builtin_amdgcn_s_setprio(3);
    const int tid = tid_(), lane = tid & 63, wave = tid >> 6, fr = lane & 15, fq = lane >> 4;
    const int h = bh % 6, b = bh / 6, e0 = wave * 16;
    const char* recs = p.rec + (size_t)bh * 256 * REC;
    const float* glp = p.glast + bh * 256;
    const int uoff = 32768 + ((e0 + fr) * 64 + fq * 4) * 2;
    u32x4 r1[8]; u32x2 u1[4], uc[4]; float g1, gl;
#define SC_LOAD(R, U, G, CK) do { const char* rn_ = recs + (size_t)(CK) * REC; \
        _Pragma("unroll") for (int i_ = 0; i_ < 8; ++i_) R[i_] = *(const u32x4*)(rn_ + (tid + 256 * i_) * 16); \
        _Pragma("unroll") for (int c_ = 0; c_ < 4; ++c_) U[c_] = *(const u32x2*)(rn_ + uoff + c_ * 32); G = glp[CK]; } while (0)
#define SC_STORE(R, BUF) do { char* nb_ = smem + (BUF) * 36864; \
        _Pragma("unroll") for (int i_ = 0; i_ < 8; ++i_) { const int cid_ = tid + 256 * i_, mat_ = cid_ >> 9, row_ = (cid_ >> 3) & 63, cc_ = cid_ & 7; \
            *(u32x4*)(nb_ + mat_ * 9216 + row_ * 144 + cc_ * 16) = R[i_]; } } while (0)
    SC_LOAD(r1, u1, g1, 0);
    SC_STORE(r1, 0);
#pragma unroll
    for (int c = 0; c < 4; ++c) uc[c] = u1[c];
    gl = g1;
    SC_LOAD(r1, u1, g1, 1);
    __syncthreads();
    f32x4 S[4];
#pragma unroll
    for (int i = 0; i < 4; ++i) S[i] = (f32x4){0.f, 0.f, 0.f, 0.f};
    auto step = [&](const char* buf, int ck) {
        const char* fb = buf + fr * 144 + fq * 16;
        bf16x8 fa[4][2], fbq[4][2];
#pragma unroll
        for (int t = 0; t < 4; ++t) { fa[t][0] = *(const bf16x8*)(fb + t * 2304); fa[t][1] = *(const bf16x8*)(fb + t * 2304 + 64); }
#pragma unroll
        for (int t = 0; t < 4; ++t) { fbq[t][0] = *(const bf16x8*)(fb + 9216 + t * 2304); fbq[t][1] = *(const bf16x8*)(fb + 9216 + t * 2304 + 64); }
        const bf16x8 Sb0 = pack2(S[0], S[1]), Sb1 = pack2(S[2], S[3]);
        f32x4 vn[4];
#pragma unroll
        for (int ct = 0; ct < 4; ++ct) {
            f32x4 acc = (f32x4){0.f, 0.f, 0.f, 0.f};
            acc = mfma(fa[ct][0], Sb0, acc); acc = mfma(fa[ct][1], Sb1, acc);
            f32x4 u; u[0] = __uint_as_float(uc[ct][0] << 16); u[1] = __uint_as_float(uc[ct][0] & 0xffff0000u);
            u[2] = __uint_as_float(uc[ct][1] << 16); u[3] = __uint_as_float(uc[ct][1] & 0xffff0000u);
            vn[ct] = u - acc;
        }
#pragma unroll
        for (int t = 0; t < 4; ++t) { fa[t][0] = *(const bf16x8*)(fb + 18432 + t * 2304); fa[t][1] = *(const bf16x8*)(fb + 18432 + t * 2304 + 64); }
        f32x4 o[4];
#pragma unroll
        for (int ct = 0; ct < 4; ++ct) {
            f32x4 t = (f32x4){0.f, 0.f, 0.f, 0.f};
            t = mfma(fbq[ct][0], Sb0, t); t = mfma(fbq[ct][1], Sb1, t);
            o[ct] = t;
        }
#pragma unroll
        for (int t = 0; t < 4; ++t) { fbq[t][0] = *(const bf16x8*)(fb + 27648 + t * 2304); fbq[t][1] = *(const bf16x8*)(fb + 27648 + t * 2304 + 64); }
        const bf16x8 vb0 = pack2(vn[0], vn[1]), vb1 = pack2(vn[2], vn[3]);
        bf16_t* op = p.hy + ((size_t)b * T_ + ck * 64 + fq * 4) * DM + h * 64 + e0 + fr;
#pragma unroll
        for (int ct = 0; ct < 4; ++ct) {
            f32x4 t = o[ct];
            t = mfma(fa[ct][0], vb0, t); t = mfma(fa[ct][1], vb1, t);
#pragma unroll
            for (int ii = 0; ii < 4; ++ii) op[(size_t)(ct * 16 + ii) * DM] = f2bf(t[ii]);
        }
#pragma unroll
        for (int dt = 0; dt < 4; ++dt) {
            f32x4 sacc = S[dt] * gl;
            sacc = mfma(fbq[dt][0], vb0, sacc); sacc = mfma(fbq[dt][1], vb1, sacc);
            S[dt] = sacc;
        }
    };
    for (int ck = 0; ck < 256; ++ck) {
        step(smem + (ck & 1) * 36864, ck);
        SC_STORE(r1, (ck + 1) & 1);
#pragma unroll
        for (int c = 0; c < 4; ++c) uc[c] = u1[c];
        gl = g1;
        { const int cn = ck + 2 < 256 ? ck + 2 : 255; SC_LOAD(r1, u1, g1, cn); }
        __syncthreads();
    }
#undef SC_LOAD
#undef SC_STORE
    __builtin_amdgcn_s_setprio(0);
}

DI void phase_gdn_final(const Params& p, int l) {
    const int tid = tid_(), sub = tid & 7;
    f32x4 g0 = *(const f32x4*)(p.gdn_norm + l * 64 + sub * 8), g1 = *(const f32x4*)(p.gdn_norm + l * 64 + sub * 8 + 4);
    const int npair = NTOK * 6, stride = gridDim.x * 32;
    for (int pr0 = blockIdx.x * 32 + (tid >> 3); pr0 < npair; pr0 += stride * 4) {
        u32x4 ov[4], zv[4];
#pragma unroll
        for (int u = 0; u < 4; ++u) {
            const int pr = pr0 + u * stride; const int prc = pr < npair ? pr : pr0;
            const int n = prc / 6, h = prc - n * 6;
            ov[u] = *(const u32x4*)(p.hy + (size_t)n * DM + h * 64 + sub * 8);
            zv[u] = *(const u32x4*)(p.proj + (size_t)n * DINP + C_Z + h * 64 + sub * 8);
        }
#pragma unroll
        for (int u = 0; u < 4; ++u) {
            const int pr = pr0 + u * stride;
            float o[8], z[8];
#pragma unroll
            for (int e = 0; e < 4; ++e) {
                o[2 * e] = __uint_as_float(ov[u][e] << 16); o[2 * e + 1] = __uint_as_float(ov[u][e] & 0xffff0000u);
                z[2 * e] = __uint_as_float(zv[u][e] << 16); z[2 * e + 1] = __uint_as_float(zv[u][e] & 0xffff0000u);
            }
            float ss = 0.f;
#pragma unroll
            for (int e = 0; e < 8; ++e) ss += o[e] * o[e];
            ss += __shfl_xor(ss, 1); ss += __shfl_xor(ss, 2); ss += __shfl_xor(ss, 4);
            const float r = rsqrtf(ss * (1.f / 64.f) + 1e-6f);
            u32x4 w;
            w[0] = pk2(o[0] * r * g0[0] * siluf_(z[0]), o[1] * r * g0[1] * siluf_(z[1]));
            w[1] = pk2(o[2] * r * g0[2] * siluf_(z[2]), o[3] * r * g0[3] * siluf_(z[3]));
            w[2] = pk2(o[4] * r * g1[0] * siluf_(z[4]), o[5] * r * g1[1] * siluf_(z[5]));
            w[3] = pk2(o[6] * r * g1[2] * siluf_(z[6]), o[7] * r * g1[3] * siluf_(z[7]));
            if (pr < npair) { const int n = pr / 6, h = pr - n * 6; *(u32x4*)(p.hy + (size_t)n * DM + h * 64 + sub * 8) = w; }
        }
    }
}

DI void phase_nsa_prep(const Params& p, int l, char* smem) {
    bf16_t* tr = (bf16_t*)smem;
    const int tid = tid_(), t = tid >> 2, part = tid & 3;
    for (int item = blockIdx.x; item < NB * 2 * 256; item += gridDim.x) {
        const int blk = item & 255, kvh = (item >> 8) & 1, b = item >> 9;
        const size_t n = (size_t)b * T_ + blk * 64 + t;
        const bf16_t* pr = p.proj + n * DINP;
#pragma unroll
        for (int w = 0; w < 2; ++w) {
            const bf16_t* src = pr + C_KV + (w == 0 ? 256 : 512) + kvh * 64 + part * 16;
            const float* g = p.k_norm + (l * 3 + 1 + w) * 64 + part * 16;
            float v[16]; float ss = 0.f;
            { const u32x4 a0 = *(const u32x4*)src, a1 = *(const u32x4*)(src + 8);
#pragma unroll
              for (int j = 0; j < 4; ++j) { v[2 * j] = __uint_as_float(a0[j] << 16); v[2 * j + 1] = __uint_as_float(a0[j] & 0xffff0000u);
                                            v[8 + 2 * j] = __uint_as_float(a1[j] << 16); v[9 + 2 * j] = __uint_as_float(a1[j] & 0xffff0000u); } }
#pragma unroll
            for (int j = 0; j < 16; ++j) ss += v[j] * v[j];
            ss += __shfl_xor(ss, 1); ss += __shfl_xor(ss, 2);
            const float r = rsqrtf(ss * (1.f / 64.f) + 1e-6f);
            bf16_t* dst = (w == 0 ? p.ksn : p.kwn) + (((size_t)(b * 2 + kvh) * T_) + blk * 64 + t) * 64 + part * 16;
            u32x4 o0, o1;
#pragma unroll
            for (int j = 0; j < 4; ++j) { o0[j] = pk2(v[2 * j] * r * g[2 * j], v[2 * j + 1] * r * g[2 * j + 1]); o1[j] = pk2(v[8 + 2 * j] * r * g[8 + 2 * j], v[9 + 2 * j] * r * g[9 + 2 * j]); }
            *(u32x4*)dst = o0; *(u32x4*)(dst + 8) = o1;
        }
#pragma unroll
        for (int g3 = 0; g3 < 3; ++g3) {
            const int h = kvh * 3 + g3;
            const bf16_t* src = pr + C_QB + h * 64 + part * 16;
            const float* g = p.q_norm + l * 64 + part * 16;
            float v[16]; float ss = 0.f;
            { const u32x4 a0 = *(const u32x4*)src, a1 = *(const u32x4*)(src + 8);
#pragma unroll
              for (int j = 0; j < 4; ++j) { v[2 * j] = __uint_as_float(a0[j] << 16); v[2 * j + 1] = __uint_as_float(a0[j] & 0xffff0000u);
                                            v[8 + 2 * j] = __uint_as_float(a1[j] << 16); v[9 + 2 * j] = __uint_as_float(a1[j] & 0xffff0000u); } }
#pragma unroll
            for (int j = 0; j < 16; ++j) ss += v[j] * v[j];
            ss += __shfl_xor(ss, 1); ss += __shfl_xor(ss, 2);
            const float r = rsqrtf(ss * (1.f / 64.f) + 1e-6f) * (0.125f * 1.44269504089f);
            bf16_t* dst = p.qn + (n * 6 + h) * 64 + part * 16;
            u32x4 o0, o1;
#pragma unroll
            for (int j = 0; j < 4; ++j) { o0[j] = pk2(v[2 * j] * r * g[2 * j], v[2 * j + 1] * r * g[2 * j + 1]); o1[j] = pk2(v[8 + 2 * j] * r * g[8 + 2 * j], v[9 + 2 * j] * r * g[9 + 2 * j]); }
            *(u32x4*)dst = o0; *(u32x4*)(dst + 8) = o1;
        }
#pragma unroll
        for (int w = 0; w < 2; ++w) {
            const bf16_t* src = pr + C_KV + (w == 0 ? 384 : 640) + kvh * 64 + part * 16;
            { const u32x4 a0 = *(const u32x4*)src, a1 = *(const u32x4*)(src + 8);
#pragma unroll
              for (int j = 0; j < 4; ++j) {
                  tr[w * 64 * 66 + (part * 16 + 2 * j) * 66 + t] = (bf16_t)(a0[j] & 0xffffu); tr[w * 64 * 66 + (part * 16 + 2 * j + 1) * 66 + t] = (bf16_t)(a0[j] >> 16);
                  tr[w * 64 * 66 + (part * 16 + 8 + 2 * j) * 66 + t] = (bf16_t)(a1[j] & 0xffffu); tr[w * 64 * 66 + (part * 16 + 9 + 2 * j) * 66 + t] = (bf16_t)(a1[j] >> 16); } }
        }
        __syncthreads();
#pragma unroll
        for (int w = 0; w < 2; ++w) {
            const int d = t;
            u32x4 o0, o1;
#pragma unroll
            for (int j = 0; j < 8; ++j) {
                const int p0 = part * 16 + 2 * j;
                const unsigned a = (unsigned)tr[w * 64 * 66 + d * 66 + PERM(p0)] | ((unsigned)tr[w * 64 * 66 + d * 66 + PERM(p0 + 1)] << 16);
                if (j < 4) o0[j] = a; else o1[j - 4] = a;
            }
            bf16_t* dst = (w == 0 ? p.vst : p.vwt) + (((size_t)(b * 2 + kvh) * 256 + blk) * 64 + d) * 64 + part * 16;
            *(u32x4*)dst = o0; *(u32x4*)(dst + 8) = o1;
        }
        __syncthreads();
    }
}

DI void phase_compress(const Params& p, int l, char* smem) {
    const int tid = tid_(), lane = tid & 63, wave = __builtin_amdgcn_readfirstlane(tid >> 6), fr = lane & 15, fq = lane >> 4;
    float* red = (float*)smem;
    for (int item = blockIdx.x; item < 512; item += gridDim.x) {
        const int ci = item & 63, kvh = (item >> 6) & 1, b = (item >> 7) & 1, kv = item >> 8;
        const int c = ci * 16 + fr;
        const int cc = c > 1022 ? 1022 : c;
        const bf16_t* xr = p.proj + ((size_t)b * T_ + 16 * cc) * DINP + C_KV + kv * 128 + kvh * 64;
        const float* pos = p.cmp_pos + (size_t)(l * 2 + kv) * 32 * 64;
        const bf16_t* w1 = p.wb_c1 + (size_t)(l * 2 + kv) * 256 * 2048 + (size_t)(wave * 64 + fr) * 2048 + fq * 8;
        const bf16_t* w2 = p.wb_c2 + (size_t)(l * 2 + kv) * 64 * 256;
        f32x4 acc[4];
#pragma unroll
        for (int i = 0; i < 4; ++i) acc[i] = (f32x4){0.f, 0.f, 0.f, 0.f};
#pragma unroll 4
        for (int ks = 0; ks < 64; ++ks) {
            const int t = ks >> 1, db = (ks & 1) * 32 + fq * 8;
            const u32x4 xv = *(const u32x4*)(xr + (size_t)t * DINP + db);
            const f32x4 p0 = *(const f32x4*)(pos + t * 64 + db), p1 = *(const f32x4*)(pos + t * 64 + db + 4);
            bf16x8 wf[4];
#pragma unroll
            for (int i = 0; i < 4; ++i) wf[i] = *(const bf16x8*)(w1 + (size_t)i * 16 * 2048 + ks * 32);
            u32x4 xb;
            xb[0] = pk2(__uint_as_float(xv[0] << 16) + p0[0], __uint_as_float(xv[0] & 0xffff0000u) + p0[1]);
            xb[1] = pk2(__uint_as_float(xv[1] << 16) + p0[2], __uint_as_float(xv[1] & 0xffff0000u) + p0[3]);
            xb[2] = pk2(__uint_as_float(xv[2] << 16) + p1[0], __uint_as_float(xv[2] & 0xffff0000u) + p1[1]);
            xb[3] = pk2(__uint_as_float(xv[3] << 16) + p1[2], __uint_as_float(xv[3] & 0xffff0000u) + p1[3]);
            const bf16x8 bx = __builtin_bit_cast(bf16x8, xb);
#pragma unroll
            for (int i = 0; i < 4; ++i) acc[i] = mfma(wf[i], bx, acc[i]);
        }
        f32x4 o[4];
#pragma unroll
        for (int i = 0; i < 4; ++i) o[i] = (f32x4){0.f, 0.f, 0.f, 0.f};
#pragma unroll
        for (int kk = 0; kk < 2; ++kk) {
            const int k2 = wave * 2 + kk;
            f32x4 a = acc[2 * kk], c2 = acc[2 * kk + 1];
#pragma unroll
            for (int e = 0; e < 4; ++e) { a[e] = siluf_(a[e]); c2[e] = siluf_(c2[e]); }
            const bf16x8 hb = pack2(a, c2);
#pragma unroll
            for (int t2 = 0; t2 < 4; ++t2) {
                const bf16_t* wr = w2 + (size_t)(t2 * 16 + fr) * 256 + k2 * 32 + fq * 4;
                const u32x2 lo = *(const u32x2*)wr, hi = *(const u32x2*)(wr + 16);
                u32x4 wv; wv[0] = lo[0]; wv[1] = lo[1]; wv[2] = hi[0]; wv[3] = hi[1];
                o[t2] = mfma(__builtin_bit_cast(bf16x8, wv), hb, o[t2]);
            }
        }
#pragma unroll
        for (int t2 = 0; t2 < 4; ++t2)
#pragma unroll
            for (int e = 0; e < 4; ++e) red[(wave * 16 + t2 * 4 + e) * 64 + lane] = o[t2][e];
        __syncthreads();
        if (wave == 0) {
#pragma unroll
            for (int t2 = 0; t2 < 4; ++t2)
#pragma unroll
                for (int e = 0; e < 4; ++e) o[t2][e] += red[(16 + t2 * 4 + e) * 64 + lane] + red[(32 + t2 * 4 + e) * 64 + lane] + red[(48 + t2 * 4 + e) * 64 + lane];
            if (kv == 0) {
                float ss = 0.f;
#pragma unroll
                for (int t2 = 0; t2 < 4; ++t2)
#pragma unroll
                    for (int e = 0; e < 4; ++e) ss += o[t2][e] * o[t2][e];
                ss += __shfl_xor(ss, 16); ss += __shfl_xor(ss, 32);
                const float r = (c <= 1022) ? rsqrtf(ss * (1.f / 64.f) + 1e-6f) : 0.f;
                const float* g = p.k_norm + (l * 3 + 0) * 64;
#pragma unroll
                for (int t2 = 0; t2 < 4; ++t2) {
                    const int n2 = t2 * 16 + fq * 4;
                    u32x2 o2; o2[0] = pk2(o[t2][0] * r * g[n2], o[t2][1] * r * g[n2 + 1]); o2[1] = pk2(o[t2][2] * r * g[n2 + 2], o[t2][3] * r * g[n2 + 3]);
                    *(u32x2*)(p.kc + (((size_t)(b * 2 + kvh) * 1024) + c) * 64 + n2) = o2;
                }
            } else {
                const float z = (c <= 1022) ? 1.f : 0.f;
                bf16_t* dst = p.vct + ((size_t)(b * 2 + kvh) * 16 + (c >> 6)) * 4096 + PINV(c & 63);
#pragma unroll
                for (int t2 = 0; t2 < 4; ++t2)
#pragma unroll
                    for (int e = 0; e < 4; ++e) dst[(t2 * 16 + fq * 4 + e) * 64] = f2bf(o[t2][e] * z);
            }
        }
        __syncthreads();
    }
}

DI void phase_pool(const Params& p, int l, char* smem) {
    float* su = (float*)smem;
    float* sd = su + 79 * 64;
    float* sw = sd + 64 * 65;
    const int tid = tid_();
    u32x4 uv[3];
    auto prefetch = [&](int it) {
        const int gi_ = it & 3; const size_t n0_ = (size_t)(it >> 2) * 64; const int tb0_ = (int)(n0_ & (T_ - 1));
#pragma unroll
        for (int k = 0; k < 3; ++k) {
            const int c = tid + 256 * k, r = c >> 3, cc = c & 7;
            const bool ok = c < 79 * 8 && tb0_ - 15 + r >= 0;
            const u32x4 v = *(const u32x4*)(p.proj + (n0_ + (ok ? r : 15) - 15) * DINP + C_UC + gi_ * 64 + cc * 8);
            uv[k] = ok ? v : (u32x4){0u, 0u, 0u, 0u};
        }
    };
    int gi_loaded = -1;
    if ((int)blockIdx.x < 512 * 4) prefetch(blockIdx.x);
    for (int item = blockIdx.x; item < 512 * 4; item += gridDim.x) {
        const int gi = item & 3, tile = item >> 2;
        const int w = 2 << gi;
        const size_t n0 = (size_t)tile * 64; const int tb0 = (int)(n0 & (T_ - 1));
#pragma unroll
        for (int k = 0; k < 3; ++k) {
            const int c = tid + 256 * k;
            if (c < 79 * 8) {
                f32x4 lo, hi;
                lo[0] = __uint_as_float(uv[k][0] << 16); lo[1] = __uint_as_float(uv[k][0] & 0xffff0000u); lo[2] = __uint_as_float(uv[k][1] << 16); lo[3] = __uint_as_float(uv[k][1] & 0xffff0000u);
                hi[0] = __uint_as_float(uv[k][2] << 16); hi[1] = __uint_as_float(uv[k][2] & 0xffff0000u); hi[2] = __uint_as_float(uv[k][3] << 16); hi[3] = __uint_as_float(uv[k][3] & 0xffff0000u);
                *(f32x4*)(su + c * 8) = lo; *(f32x4*)(su + c * 8 + 4) = hi;
            }
        }
        if (gi != gi_loaded) {
#pragma unroll
            for (int k = 0; k < 4; ++k) *(f32x4*)(sw + (tid + 256 * k) * 4) = *(const f32x4*)(p.pool_w + ((size_t)(l * 4 + gi) * 64) * 64 + (tid + 256 * k) * 4);
            gi_loaded = gi;
        }
        { const int nxt = item + (int)gridDim.x; prefetch(nxt < 512 * 4 ? nxt : item); }
        __syncthreads();
        for (int i = tid; i < 4096; i += 256) {
            const int t = i >> 6, c = i & 63; const int tb = tb0 + t;
            float s_ = 0.f;
            for (int k = 0; k < w; ++k) s_ += su[(15 + t - k) * 64 + c];
            const float cnt = (float)(tb + 1 < w ? tb + 1 : w);
            sd[t * 65 + c] = s_ / cnt - su[(15 + t) * 64 + c];
        }
        __syncthreads();
        {
            const int t = tid >> 2, dq = (tid & 3) * 16;
            float acc[16];
#pragma unroll
            for (int j = 0; j < 16; ++j) acc[j] = 0.f;
            for (int c = 0; c < 64; ++c) {
                const float dv = sd[t * 65 + c];
#pragma unroll
                for (int j4 = 0; j4 < 4; ++j4) {
                    const f32x4 w4 = *(const f32x4*)(sw + c * 64 + dq + j4 * 4);
                    acc[j4 * 4 + 0] += dv * w4[0]; acc[j4 * 4 + 1] += dv * w4[1]; acc[j4 * 4 + 2] += dv * w4[2]; acc[j4 * 4 + 3] += dv * w4[3];
                }
            }
            const float* sc = p.pool_scale + l * 256 + gi * 64 + dq;
            u32x4 o0, o1;
#pragma unroll
            for (int j = 0; j < 4; ++j) { o0[j] = pk2(acc[2 * j] * sc[2 * j], acc[2 * j + 1] * sc[2 * j + 1]); o1[j] = pk2(acc[8 + 2 * j] * sc[8 + 2 * j], acc[9 + 2 * j] * sc[9 + 2 * j]); }
            bf16_t* dst = p.hy + (n0 + t) * DM + 768 + gi * 64 + dq;
            *(u32x4*)dst = o0; *(u32x4*)(dst + 8) = o1;
        }
        __syncthreads();
    }
}

DI void st_tile(const bf16_t* Kp, const bf16x8 (&qf)[2], int fr, int fq, f32x4 (&st)[4]) {
#pragma unroll
    for (int k4 = 0; k4 < 4; ++k4) {
        const bf16_t* kr = Kp + (k4 * 16 + fr) * 64 + fq * 8;
        f32x4 a = (f32x4){0.f, 0.f, 0.f, 0.f};
        a = mfma(*(const bf16x8*)kr, qf[0], a); a = mfma(*(const bf16x8*)(kr + 32), qf[1], a);
        st[k4] = a;
    }
}
DI void pv_tile(const bf16_t* VTp, const f32x4 (&pt)[4], int fr, int fq, f32x4 (&o)[4]) {
    const bf16x8 pb0 = pack2(pt[0], pt[1]), pb1 = pack2(pt[2], pt[3]);
#pragma unroll
    for (int dt = 0; dt < 4; ++dt) {
        const bf16_t* vr = VTp + (dt * 16 + fr) * 64 + fq * 8;
        o[dt] = mfma(*(const bf16x8*)vr, pb0, o[dt]); o[dt] = mfma(*(const bf16x8*)(vr + 32), pb1, o[dt]);
    }
}
template <bool FULL = false>
DI void online_step(f32x4 (&st)[4], unsigned vmask, float& m, float& lsum, f32x4 (&o)[4]) {
    float tmax = -1e30f;
#pragma unroll
    for (int k4 = 0; k4 < 4; ++k4)
#pragma unroll
        for (int ii = 0; ii < 4; ++ii) if (FULL || (vmask & (1u << (k4 * 4 + ii)))) tmax = fmaxf(tmax, st[k4][ii]);
    tmax = fmaxf(tmax, __shfl_xor(tmax, 16)); tmax = fmaxf(tmax, __shfl_xor(tmax, 32));
    const float mn = fmaxf(m, tmax), alpha = __builtin_amdgcn_exp2f(m - mn);
    m = mn;
    float ps = 0.f;
#pragma unroll
    for (int k4 = 0; k4 < 4; ++k4)
#pragma unroll
        for (int ii = 0; ii < 4; ++ii) { const float pv = (FULL || (vmask & (1u << (k4 * 4 + ii)))) ? __builtin_amdgcn_exp2f(st[k4][ii] - mn) : 0.f; st[k4][ii] = pv; ps += pv; }
    lsum = lsum * alpha + ps;
#pragma unroll
    for (int dt = 0; dt < 4; ++dt) o[dt] *= alpha;
}

DI void ldfrag(const bf16_t* P, int fr, int fq, bf16x8 (&f)[4][2]) {
#pragma unroll
    for (int k4 = 0; k4 < 4; ++k4) { f[k4][0] = *(const bf16x8*)(P + (k4 * 16 + fr) * 64 + fq * 8); f[k4][1] = *(const bf16x8*)(P + (k4 * 16 + fr) * 64 + 32 + fq * 8); }
}
DI void st_from(const bf16x8 (&kf)[4][2], const bf16x8 (&qf)[2], f32x4 (&st)[4], float c0 = 0.f) {
#pragma unroll
    for (int k4 = 0; k4 < 4; ++k4) { f32x4 a = (f32x4){c0, c0, c0, c0}; a = mfma(kf[k4][0], qf[0], a); a = mfma(kf[k4][1], qf[1], a); st[k4] = a; }
}
DI void pv_from(const bf16x8 (&vf)[4][2], const f32x4 (&pt)[4], f32x4 (&o)[4]) {
    const bf16x8 pb0 = pack2(pt[0], pt[1]), pb1 = pack2(pt[2], pt[3]);
#pragma unroll
    for (int dt = 0; dt < 4; ++dt) { o[dt] = mfma(vf[dt][0], pb0, o[dt]); o[dt] = mfma(vf[dt][1], pb1, o[dt]); }
}
template <bool FULL = false>
DI void stats_step(const f32x4 (&st)[4], unsigned vmask, float& m, float& lsum) {
    float tmax = -1e30f;
#pragma unroll
    for (int k4 = 0; k4 < 4; ++k4)
#pragma unroll
        for (int ii = 0; ii < 4; ++ii) if (FULL || (vmask & (1u << (k4 * 4 + ii)))) tmax = fmaxf(tmax, st[k4][ii]);
    tmax = fmaxf(tmax, __shfl_xor(tmax, 16)); tmax = fmaxf(tmax, __shfl_xor(tmax, 32));
    const float mn = fmaxf(m, tmax), alpha = __builtin_amdgcn_exp2f(m - mn);
    m = mn;
    float ps = 0.f;
#pragma unroll
    for (int k4 = 0; k4 < 4; ++k4)
#pragma unroll
        for (int ii = 0; ii < 4; ++ii) ps += (FULL || (vmask & (1u << (k4 * 4 + ii)))) ? __builtin_amdgcn_exp2f(st[k4][ii] - mn) : 0.f;
    lsum = lsum * alpha + ps;
}
DI float wave_max(float v) {
    int x = __float_as_int(v);
    x = __float_as_int(fmaxf(__int_as_float(x), __int_as_float(__builtin_amdgcn_update_dpp(x, x, 0xB1, 0xF, 0xF, false))));
    x = __float_as_int(fmaxf(__int_as_float(x), __int_as_float(__builtin_amdgcn_update_dpp(x, x, 0x4E, 0xF, 0xF, false))));
    x = __float_as_int(fmaxf(__int_as_float(x), __int_as_float(__builtin_amdgcn_update_dpp(x, x, 0x141, 0xF, 0xF, false))));
    x = __float_as_int(fmaxf(__int_as_float(x), __int_as_float(__builtin_amdgcn_update_dpp(x, x, 0x140, 0xF, 0xF, false))));
    const float a = __int_as_float(__builtin_amdgcn_readlane(x, 0)), b = __int_as_float(__builtin_amdgcn_readlane(x, 16));
    const float c = __int_as_float(__builtin_amdgcn_readlane(x, 32)), d = __int_as_float(__builtin_amdgcn_readlane(x, 48));
    return fmaxf(fmaxf(a, b), fmaxf(c, d));
}
DI void nsa_item(const Params& p, int bk, int qb, char* smem, float Mb) {
    const int tid = tid_(), lane = tid & 63, wave = __builtin_amdgcn_readfirstlane(tid >> 6), fr = lane & 15, fq = lane >> 4;
    const int b = bk >> 1, kvh = bk & 1, cur = qb;
    const int t0 = qb * 64 + wave * 16;
    const size_t n0 = (size_t)b * T_ + t0, nb0 = (size_t)b * T_ + qb * 64;
    float* imp = (float*)(smem + wave * 17664);
    int* sel = (int*)(smem + wave * 17664 + 16640);
    unsigned long long* masks = (unsigned long long*)(smem + 70656);
    float* acc = (float*)smem;
    float* accl = acc + 64 * 193;
    const bf16_t* gatep = p.proj + (n0 + fr) * DINP + C_GATE + kvh * 9;
    const int tq = t0 + fr;
    const int nforced = cur >= 2 ? 3 : cur + 1;

    {
        const int nv = tq >= 31 ? ((tq - 31) >> 4) + 1 : 0;
        const int nvmax = t0 >= 16 ? (t0 >> 4) : 0;
        const int ntile = (nvmax + 63) >> 6;
        const bf16_t* KCp = p.kc + (size_t)bk * 1024 * 64;
        const bf16_t* VCp = p.vct + (size_t)bk * 16 * 4096;
        bf16x8 qf[3][2];
#pragma unroll
        for (int g = 0; g < 3; ++g) {
            qf[g][0] = *(const bf16x8*)(p.qn + ((n0 + fr) * 6 + kvh * 3 + g) * 64 + fq * 8);
            qf[g][1] = *(const bf16x8*)(p.qn + ((n0 + fr) * 6 + kvh * 3 + g) * 64 + 32 + fq * 8);
        }
        float m[3], ls[3];
#pragma unroll
        for (int g = 0; g < 3; ++g) { m[g] = -1e30f; ls[g] = 0.f; }
        {
            bf16x8 kn[4][2];
            if (ntile > 0) ldfrag(KCp, fr, fq, kn);
            for (int kt = 0; kt < ntile; ++kt) {
                bf16x8 kf[4][2];
#pragma unroll
                for (int k4 = 0; k4 < 4; ++k4) { kf[k4][0] = kn[k4][0]; kf[k4][1] = kn[k4][1]; }
                ldfrag(KCp + (kt + 1 < ntile ? kt + 1 : kt) * 4096, fr, fq, kn);
                unsigned vm = 0;
#pragma unroll
                for (int k4 = 0; k4 < 4; ++k4)
#pragma unroll
                    for (int ii = 0; ii < 4; ++ii) if (kt * 64 + k4 * 16 + fq * 4 + ii < nv) vm |= 1u << (k4 * 4 + ii);
                const bool full = (kt + 1) * 64 <= nvmax - 1;
                if (full) {
#pragma unroll
                    for (int g = 0; g < 3; ++g) { f32x4 st[4]; st_from(kf, qf[g], st); stats_step<true>(st, vm, m[g], ls[g]); }
                } else {
#pragma unroll
                    for (int g = 0; g < 3; ++g) { f32x4 st[4]; st_from(kf, qf[g], st); stats_step(st, vm, m[g], ls[g]); }
                }
            }
        }
        float inv[3];
#pragma unroll
        for (int g = 0; g < 3; ++g) { float l2 = ls[g]; l2 += __shfl_xor(l2, 16); l2 += __shfl_xor(l2, 32); inv[g] = l2 > 0.f ? 1.f / l2 : 0.f; }
        f32x4 o[3][4];
#pragma unroll
        for (int g = 0; g < 3; ++g)
#pragma unroll
            for (int dt = 0; dt < 4; ++dt) o[g][dt] = (f32x4){0.f, 0.f, 0.f, 0.f};
        float carry = 0.f;
        for (int kt = 0; kt < ntile; ++kt) {
            bf16x8 kf[4][2], vf[4][2];
            ldfrag(KCp + kt * 4096, fr, fq, kf);
            ldfrag(VCp + kt * 4096, fr, fq, vf);
            float s4[4], p3[4];
#pragma unroll
            for (int k4 = 0; k4 < 4; ++k4) { s4[k4] = 0.f; p3[k4] = 0.f; }
#pragma unroll
            for (int g = 0; g < 3; ++g) {
                f32x4 st[4];
                st_from(kf, qf[g], st);
#pragma unroll
                for (int k4 = 0; k4 < 4; ++k4) {
#pragma unroll
                    for (int ii = 0; ii < 4; ++ii) {
                        const float pv = (kt * 64 + k4 * 16 + fq * 4 + ii < nv) ? __builtin_amdgcn_exp2f(st[k4][ii] - m[g]) * inv[g] : 0.f;
                        st[k4][ii] = pv; s4[k4] += pv;
                    }
                    p3[k4] += st[k4][3];
                }
                pv_from(vf, st, o[g]);
            }
            float nb[4];
#pragma unroll
            for (int k4 = 0; k4 < 4; ++k4) nb[k4] = __shfl(p3[k4], (lane + 48) & 63);
#pragma unroll
            for (int k4 = 0; k4 < 4; ++k4) {
                const float add = fq >= 1 ? nb[k4] : (k4 >= 1 ? nb[k4 >= 1 ? k4 - 1 : 0] : carry);
                imp[fr * 260 + kt * 16 + k4 * 4 + fq] = s4[k4] + add;
            }
            carry = nb[3];
        }
#pragma unroll
        for (int g = 0; g < 3; ++g) {
            const float gate = sigmoidf_(bf2f(gatep[g * 3 + 0]));
#pragma unroll
            for (int dt = 0; dt < 4; ++dt) {
                const f32x4 r = o[g][dt] * gate;
                u32x2 o2; o2[0] = pk2(r[0], r[1]); o2[1] = pk2(r[2], r[3]);
                *(u32x2*)(p.hy + (n0 + fr) * DM + 384 + (kvh * 3 + g) * 64 + dt * 16 + fq * 4) = o2;
            }
        }
    }
    __builtin_amdgcn_fence(__ATOMIC_SEQ_CST, "workgroup");

    {
        const int need = 16 - nforced;
        const int ncand = cur >= 2 ? cur - 2 : 0;
#pragma unroll 1
        for (int qi = 0; qi < 16; qi += 4) {
#pragma unroll
            for (int u = 0; u < 4; ++u)
                if (lane < 16) {
                    int v = -1;
                    if (ncand <= need && lane >= nforced && lane - nforced < ncand) v = lane - nforced + 1;
                    sel[(qi + u) * 16 + lane] = v;
                }
            if (ncand > need) {
                float key[4][4];
#pragma unroll
                for (int u = 0; u < 4; ++u)
#pragma unroll
                    for (int r = 0; r < 4; ++r) {
                        const int j = lane + 64 * r;
                        key[u][r] = (j >= 1 && j <= cur - 2) ? imp[(qi + u) * 260 + j] : -1.f;
                    }
                for (int s = 0; s < need; ++s) {
#pragma unroll
                    for (int u = 0; u < 4; ++u) {
                        const float best = wave_max(fmaxf(fmaxf(key[u][0], key[u][1]), fmaxf(key[u][2], key[u][3])));
                        int jstar = 1 << 20;
#pragma unroll
                        for (int r = 3; r >= 0; --r) {
                            const unsigned long long bm = __ballot(key[u][r] == best);
                            if (bm) jstar = 64 * r + (int)__builtin_ctzll(bm);
                        }
#pragma unroll
                        for (int r = 0; r < 4; ++r) if (lane + 64 * r == jstar) key[u][r] = -1.f;
                        if (lane == 0) sel[(qi + u) * 16 + nforced + s] = jstar;
                    }
                }
            }
        }
    }
    __builtin_amdgcn_fence(__ATOMIC_SEQ_CST, "workgroup");
#pragma unroll
    for (int e = lane; e < 256; e += 64) {
        const int jb = sel[e];
        if ((e & 15) >= nforced && jb > 0) atomicOr(&masks[jb], 1ull << (wave * 16 + (e >> 4)));
    }
    __syncthreads();

    const bf16_t* KS = p.ksn + (size_t)bk * T_ * 64;
    const bf16_t* VS = p.vst + (size_t)bk * 256 * 4096;
    {
        char* tb = smem;
        bf16x8 qf[3][2];
#pragma unroll
        for (int g = 0; g < 3; ++g) {
            qf[g][0] = *(const bf16x8*)(p.qn + ((n0 + fr) * 6 + kvh * 3 + g) * 64 + fq * 8);
            qf[g][1] = *(const bf16x8*)(p.qn + ((n0 + fr) * 6 + kvh * 3 + g) * 64 + 32 + fq * 8);
        }
        float ls[3];
        f32x4 o[3][4];
#pragma unroll
        for (int g = 0; g < 3; ++g) {
            ls[g] = 0.f;
#pragma unroll
            for (int dt = 0; dt < 4; ++dt) o[g][dt] = (f32x4){0.f, 0.f, 0.f, 0.f};
        }
        auto next_valid = [&](int j, unsigned long long& mout) {
            for (; j <= cur; ++j) {
                if (j == 0 || j >= cur - 1) { mout = ~0ull; break; }
                const unsigned long long mm = masks[j];
                const unsigned mlo = __builtin_amdgcn_readfirstlane((unsigned)mm), mhi = __builtin_amdgcn_readfirstlane((unsigned)(mm >> 32));
                mout = ((unsigned long long)mhi << 32) | mlo;
                if (mout) break;
            }
            return j;
        };
        u32x4 rg[4];
        const int l_row = (tid >> 3) & 31, l_cc = tid & 7;
        auto gload = [&](int j) {
#pragma unroll
            for (int i = 0; i < 4; ++i) {
                const bf16_t* src = ((i >> 1) ? VS : KS) + (size_t)j * 4096 + (l_row + 32 * (i & 1)) * 64 + l_cc * 8;
                rg[i] = *(const u32x4*)src;
            }
        };
        auto lstore = [&](int bsel) {
#pragma unroll
            for (int i = 0; i < 4; ++i) *(u32x4*)(tb + bsel * 18432 + (i >> 1) * 9216 + (l_row + 32 * (i & 1)) * 144 + l_cc * 16) = rg[i];
        };
        unsigned long long m = 0ull, mn = 0ull;
        int j = next_valid(0, m);
        gload(j); lstore(0);
        __syncthreads();
        int bsel = 0;
        while (j <= cur) {
            const int jn = next_valid(j + 1, mn);
            gload(jn <= cur ? jn : j);
            const unsigned sub = (unsigned)(m >> (wave * 16)) & 0xffffu;
            if (sub) {
                const char* kb_ = tb + bsel * 18432 + fr * 144 + fq * 16;
                bf16x8 kf[4][2], vf[4][2];
#pragma unroll
                for (int k4 = 0; k4 < 4; ++k4) {
                    kf[k4][0] = *(const bf16x8*)(kb_ + k4 * 16 * 144); kf[k4][1] = *(const bf16x8*)(kb_ + k4 * 16 * 144 + 64);
                    vf[k4][0] = *(const bf16x8*)(kb_ + 9216 + k4 * 16 * 144); vf[k4][1] = *(const bf16x8*)(kb_ + 9216 + k4 * 16 * 144 + 64);
                }
                const bool mine = (sub >> fr) & 1u;
                const float Ml = mine ? Mb : 3.0e38f;
                const bool diag = (j == cur);
#pragma unroll
                for (int g = 0; g < 3; ++g) {
                    f32x4 st[4];
                    st_from(kf, qf[g], st, -Ml);
                    if (diag) {
#pragma unroll
                        for (int k4 = 0; k4 < 4; ++k4)
#pragma unroll
                            for (int ii = 0; ii < 4; ++ii) {
                                const float pv = (j * 64 + k4 * 16 + fq * 4 + ii <= tq) ? __builtin_amdgcn_exp2f(st[k4][ii]) : 0.f;
                                st[k4][ii] = pv; ls[g] += pv;
                            }
                    } else {
#pragma unroll
                        for (int k4 = 0; k4 < 4; ++k4)
#pragma unroll
                            for (int ii = 0; ii < 4; ++ii) { const float pv = __builtin_amdgcn_exp2f(st[k4][ii]); st[k4][ii] = pv; ls[g] += pv; }
                    }
                    pv_from(vf, st, o[g]);
                }
            }
            lstore(bsel ^ 1);
            __syncthreads();
            bsel ^= 1; j = jn; m = mn;
        }
#pragma unroll
        for (int g = 0; g < 3; ++g) {
            float l2 = ls[g]; l2 += __shfl_xor(l2, 16); l2 += __shfl_xor(l2, 32);
            float* ar = acc + (wave * 16 + fr) * 193 + g * 64 + fq * 4;
#pragma unroll
            for (int dt = 0; dt < 4; ++dt)
#pragma unroll
                for (int ii = 0; ii < 4; ++ii) ar[dt * 16 + ii] = o[g][dt][ii];
            if (fq == 0) accl[(wave * 16 + fr) * 3 + g] = l2;
        }
    }
    __syncthreads();
    masks[tid] = 0ull;

    {
        const bf16_t* KW = p.kwn + (size_t)bk * T_ * 64;
        const bf16_t* VW = p.vwt + (size_t)bk * 256 * 4096;
        const int lo = t0 - 511 > 0 ? t0 - 511 : 0;
        const int kb0 = lo >> 6, kb1 = t0 >> 6;
        bf16x8 qf[3][2];
#pragma unroll
        for (int g = 0; g < 3; ++g) {
            qf[g][0] = *(const bf16x8*)(p.qn + ((n0 + fr) * 6 + kvh * 3 + g) * 64 + fq * 8);
            qf[g][1] = *(const bf16x8*)(p.qn + ((n0 + fr) * 6 + kvh * 3 + g) * 64 + 32 + fq * 8);
        }
        float m[3], ls[3];
        f32x4 o[3][4];
#pragma unroll
        for (int g = 0; g < 3; ++g) {
            m[g] = -1e30f; ls[g] = 0.f;
#pragma unroll
            for (int dt = 0; dt < 4; ++dt) o[g][dt] = (f32x4){0.f, 0.f, 0.f, 0.f};
        }
        for (int kb = kb0; kb <= kb1; ++kb) {
            bf16x8 kf[4][2], vf[4][2];
            ldfrag(KW + (size_t)kb * 4096, fr, fq, kf);
            ldfrag(VW + (size_t)kb * 4096, fr, fq, vf);
            unsigned vm = 0;
#pragma unroll
            for (int k4 = 0; k4 < 4; ++k4)
#pragma unroll
                for (int ii = 0; ii < 4; ++ii) { const int kp = kb * 64 + k4 * 16 + fq * 4 + ii; if (kp <= tq && kp > tq - 512) vm |= 1u << (k4 * 4 + ii); }
            const bool full = (kb * 64 + 63 <= t0) && (kb * 64 > t0 + 15 - 512);
            if (full) {
#pragma unroll
                for (int g = 0; g < 3; ++g) { f32x4 st[4]; st_from(kf, qf[g], st); online_step<true>(st, vm, m[g], ls[g], o[g]); pv_from(vf, st, o[g]); }
            } else {
#pragma unroll
                for (int g = 0; g < 3; ++g) { f32x4 st[4]; st_from(kf, qf[g], st); online_step(st, vm, m[g], ls[g], o[g]); pv_from(vf, st, o[g]); }
            }
        }
#pragma unroll
        for (int g = 0; g < 3; ++g) {
            const int h = kvh * 3 + g;
            float lsum = ls[g];
            lsum += __shfl_xor(lsum, 16); lsum += __shfl_xor(lsum, 32);
            const float inv = lsum > 0.f ? 1.f / lsum : 0.f;
            const float gate2 = sigmoidf_(bf2f(gatep[g * 3 + 2])) * inv;
            const float sl = accl[(wave * 16 + fr) * 3 + g];
            const float gate1 = sigmoidf_(bf2f(gatep[g * 3 + 1])) * (sl > 0.f ? 1.f / sl : 0.f);
            const float* ar = acc + (wave * 16 + fr) * 193 + g * 64 + fq * 4;
#pragma unroll
            for (int dt = 0; dt < 4; ++dt) {
                bf16_t* yp = p.hy + (n0 + fr) * DM + 384 + h * 64 + dt * 16 + fq * 4;
                const u32x2 pc = *(const u32x2*)yp;
                f32x4 r = o[g][dt] * gate2;
                r[0] += ar[dt * 16 + 0] * gate1 + __uint_as_float(pc[0] << 16); r[1] += ar[dt * 16 + 1] * gate1 + __uint_as_float(pc[0] & 0xffff0000u);
                r[2] += ar[dt * 16 + 2] * gate1 + __uint_as_float(pc[1] << 16); r[3] += ar[dt * 16 + 3] * gate1 + __uint_as_float(pc[1] & 0xffff0000u);
                u32x2 o2; o2[0] = pk2(r[0], r[1]); o2[1] = pk2(r[2], r[3]);
                *(u32x2*)yp = o2;
            }
        }
    }
    __syncthreads();
}

DI void phase_nsa(const Params& p, int l, int first, char* smem) {
    const int lane = tid_() & 63;
    float gq = fabsf(p.q_norm[l * 64 + lane]), gk = fabsf(p.k_norm[(l * 3 + 1) * 64 + lane]);
#pragma unroll
    for (int o = 32; o >= 1; o >>= 1) { gq = fmaxf(gq, __shfl_xor(gq, o)); gk = fmaxf(gk, __shfl_xor(gk, o)); }
    const float Mb = (8.f * gq * gk * 1.02f + 0.05f) * 1.44269504089f;
    const int bk = ((int)blockIdx.x & 7) >> 1;
    ((unsigned long long*)(smem + 70656))[tid_()] = 0ull;
    volatile int* slot = (volatile int*)(smem + 72704);
    __syncthreads();
    for (;;) {
        if (tid_() == 0) *slot = atomicAdd(p.nsa_ctr + l * 4 + bk, 1);
        __syncthreads();
        const int i = *slot;
        if (i >= 256) break;
        nsa_item(p, bk, 255 - i, smem, Mb);
    }
}

#define XB_TMO      128
#define XB_XCNT(j)  (256  + 64 * (j))
#define XB_XSUB(j)  (1280 + 64 * (j))
#define XB_XGEN(j)  (2304 + 64 * (j))
#define XB_TOP      3328
#define XB_TOPGEN   3392
#define XCD_BAR_WORDS 3456
#define XB_SPIN_CAP (1u << 18)
#define LAS __attribute__((address_space(3)))
DI unsigned xb_ld(unsigned* p)              { return __hip_atomic_load(p, __ATOMIC_RELAXED, __HIP_MEMORY_SCOPE_AGENT); }
DI unsigned xb_add(unsigned* p, unsigned v) { return __hip_atomic_fetch_add(p, v, __ATOMIC_RELAXED, __HIP_MEMORY_SCOPE_AGENT); }
DI unsigned xb_xcc_id() { return (unsigned)__builtin_amdgcn_s_getreg((3 << 11) | 20) & 0xFu; }
#define XB_SPIN(cond, bar) do { unsigned _sp = 0; while (cond) { __builtin_amdgcn_s_sleep(1); \
    if ((++_sp & 255u) == 0u) { if (xb_ld(&(bar)[XB_TMO])) break; if (_sp > XB_SPIN_CAP) { atomicAdd(&(bar)[XB_TMO], 1u); break; } } } } while (0)
struct XcdBarrier { unsigned* bar; unsigned x; volatile LAS unsigned* st; };
DI XcdBarrier xcd_barrier_post(unsigned* bar, volatile LAS unsigned* st) {
    XcdBarrier b; b.bar = bar; b.x = xb_xcc_id(); b.st = st;
    if (threadIdx.x == 0) (void)xb_add(&bar[XB_XCNT(b.x)], 1u);
    return b;
}
DI void xcd_barrier_complete(unsigned* bar, unsigned x, unsigned& nloc, unsigned& nx) {
    const unsigned G = gridDim.x * gridDim.y * gridDim.z;
    unsigned sum, cnt, mine, sp = 0u;
    for (;;) {
        sum = 0u; cnt = 0u; mine = 0u;
#pragma unroll
        for (unsigned j = 0; j < 16; ++j) { const unsigned c = xb_ld(&bar[XB_XCNT(j)]); sum += c; cnt += (c > 0u) ? 1u : 0u; mine = (j == x) ? c : mine; }
        if (sum == G) break;
        __builtin_amdgcn_s_sleep(1);
        if ((++sp & 255u) == 0u) { if (xb_ld(&bar[XB_TMO])) break; if (sp > XB_SPIN_CAP) { atomicAdd(&bar[XB_TMO], 1u); break; } }
    }
    nloc = mine > 0u ? mine : 1u; nx = cnt > 0u ? cnt : 1u;
}
DI void xcd_barrier(const XcdBarrier& b) {
    asm volatile("s_waitcnt vmcnt(0)" ::: "memory");
    __syncthreads();
    if (threadIdx.x == 0) {
        unsigned* bar = b.bar;
        __builtin_amdgcn_s_waitcnt(0);
        unsigned nloc = b.st[0], nx = b.st[1];
        if (nloc == 0u) { xcd_barrier_complete(bar, b.x, nloc, nx); b.st[0] = nloc; b.st[1] = nx; }
        const unsigned old = xb_add(&bar[XB_XSUB(b.x)], 1u);
        const unsigned gen = old / nloc;
        if (old + 1u == (gen + 1u) * nloc) {
            __builtin_amdgcn_fence(__ATOMIC_RELEASE, "agent");
            asm volatile("s_waitcnt vmcnt(0)" ::: "memory");
            const unsigned og = xb_add(&bar[XB_TOP], 1u);
            const unsigned tg = og / nx;
            if (og + 1u == (tg + 1u) * nx) xb_add(&bar[XB_TOPGEN], 1u);
            else XB_SPIN(xb_ld(&bar[XB_TOPGEN]) == tg, bar);
            __builtin_amdgcn_fence(__ATOMIC_ACQUIRE, "agent");
            xb_add(&bar[XB_XGEN(b.x)], 1u);
            asm volatile("s_waitcnt vmcnt(0)" ::: "memory");
        } else {
            XB_SPIN(xb_ld(&bar[XB_XGEN(b.x)]) == gen, bar);
            __builtin_amdgcn_fence(__ATOMIC_ACQUIRE, "agent");
            asm volatile("s_waitcnt vmcnt(0)" ::: "memory");
        }
    }
    __syncthreads();
}

#ifndef PHDUP
#define PHDUP 0
#endif
#ifndef PHMASK
#define PHMASK 0xffff
#endif
DI void run_phase(const Params& p, int ph, int l, char* smem) {
    if (!((PHMASK >> ph) & 1)) return;
    const float* xin = (l == 0) ? p.x : p.out;
    switch (ph) {
    case 0: phase_convert(p, smem); break;
    case 1: phase_rmsnorm(xin, p.norm_mix + l * DM, p.hy); break;
    case 2: gemm_phase<0>(p.hy, p.wb_in + (size_t)l * DINP * DM, NTOK, DINP, DM, p.proj, p.side, nullptr, nullptr, smem,
                          l == 0 ? nullptr : p.ssq + 1 * NTOK); break;
    case 3:
        phase_gdn_prep(p, l, smem);
        phase_nsa_prep(p, l, smem);
        phase_compress(p, l, smem);
        phase_pool(p, l, smem);
        break;
    case 4:
        if (blockIdx.x < NSCAN) { gdn_scan_block(p, blockIdx.x, smem); if (PHDUP & 0x400) gdn_scan_block(p, blockIdx.x, smem); }
        phase_nsa(p, l, NSCAN, smem);
        break;
    case 5: phase_gdn_final(p, l); break;
    case 6: gemm_phase<2>(p.hy, p.wb_out + (size_t)l * DM * DM, NTOK, DM, DM, nullptr, nullptr, xin, p.out, smem,
                          nullptr, p.h2, p.norm_ffn + l * DM, p.ssq + (l == 0 ? 0 : 2) * NTOK); break;
    case 8: gemm_phase<1>(p.h2, p.wb_f1 + (size_t)l * DFF * DM, NTOK, DFF, DM, p.hid, nullptr, nullptr, nullptr, smem,
                          p.ssq + (l == 0 ? 0 : 2) * NTOK); break;
    case 9:
        if (l == 0) gemm_phase<2>(p.hid, p.wb_f2 + (size_t)l * DM * DFF, NTOK, DM, DFF, nullptr, nullptr, p.out, p.out, smem,
                                  nullptr, p.hy, p.norm_mix + DM, p.ssq + 1 * NTOK);
        else gemm_phase<2>(p.hid, p.wb_f2 + (size_t)l * DM * DFF, NTOK, DM, DFF, nullptr, nullptr, p.out, p.out, smem);
        break;
    }
}

#if MEGA
__global__ void __launch_bounds__(256, 2) mega_kernel(Params p) {
    extern __shared__ __attribute__((aligned(16))) char smem[];
    cg::grid_group grid = cg::this_grid();
    volatile LAS unsigned* st = (volatile LAS unsigned*)(smem + LDS_BYTES);
    if (threadIdx.x < 4) st[threadIdx.x] = 0u;
    __syncthreads();
    const XcdBarrier xb = xcd_barrier_post(p.bar, st);
    run_phase(p, 0, 0, smem);
    run_phase(p, 1, 0, smem);
    grid.sync();
#define RUNPH(PH) do { run_phase(p, PH, l, smem); xcd_barrier(xb); if ((PHDUP >> PH) & 1) { run_phase(p, PH, l, smem); xcd_barrier(xb); } } while (0)
#pragma unroll 1
    for (int l = 0; l < 2; ++l) {
        RUNPH(2); RUNPH(3); RUNPH(4); RUNPH(5); RUNPH(6); RUNPH(8);
        run_phase(p, 9, l, smem);
        if (l == 0) xcd_barrier(xb);
    }
}
#endif

extern "C" void kernel_launch(void* const* d_in, const int* in_sizes, int n_in, void* d_out, int out_size, void* d_ws, size_t ws_size,
                              hipStream_t stream) {
    Params p{};
    p.x = (const float*)d_in[0]; p.norm_mix = (const float*)d_in[1]; p.w_in = (const float*)d_in[2]; p.conv_w = (const float*)d_in[3];
    p.a_log = (const float*)d_in[4]; p.dt_bias = (const float*)d_in[5]; p.gdn_norm = (const float*)d_in[6]; p.q_norm = (const float*)d_in[7];
    p.k_norm = (const float*)d_in[8]; p.cmp_pos = (const float*)d_in[9]; p.cmp_w1 = (const float*)d_in[10]; p.cmp_w2 = (const float*)d_in[11];
    p.pool_w = (const float*)d_in[12]; p.pool_scale = (const float*)d_in[13]; p.w_out = (const float*)d_in[14]; p.norm_ffn = (const float*)d_in[15];
    p.w_ffn1 = (const float*)d_in[16]; p.w_ffn2 = (const float*)d_in[17];
    p.out = (float*)d_out;
    char* ws = (char*)d_ws; size_t off = 0;
    auto take = [&](size_t bytes) { char* r = ws + off; off += (bytes + 255) & ~(size_t)255; return r; };
    p.wb_in = (bf16_t*)take((size_t)2 * DINP * DM * 2);
    p.wb_out = (bf16_t*)take((size_t)2 * DM * DM * 2);
    p.wb_f1 = (bf16_t*)take((size_t)2 * DFF * DM * 2);
    p.wb_f2 = (bf16_t*)take((size_t)2 * DFF * DM * 2);
    p.wb_c1 = (bf16_t*)take((size_t)4 * 256 * 2048 * 2);
    p.wb_c2 = (bf16_t*)take((size_t)4 * 64 * 256 * 2);
    p.hy = (bf16_t*)take((size_t)NTOK * DM * 2);
    p.proj = (bf16_t*)take((size_t)NTOK * DINP * 2);
    p.hid = p.proj;
    p.rec = take((size_t)3072 * REC);
    p.glast = (float*)take(3072 * 4);
    p.side = (float*)take((size_t)NTOK * 12 * 4);
    p.qn = (bf16_t*)take((size_t)NTOK * 384 * 2);
    p.ksn = (bf16_t*)take((size_t)NTOK * 128 * 2);
    p.kwn = (bf16_t*)take((size_t)NTOK * 128 * 2);
    p.vst = (bf16_t*)take((size_t)NTOK * 128 * 2);
    p.vwt = (bf16_t*)take((size_t)NTOK * 128 * 2);
    p.kc = (bf16_t*)take((size_t)4 * 1024 * 64 * 2);
    p.vct = (bf16_t*)take((size_t)4 * 16 * 4096 * 2);
    p.bar = (unsigned*)take((size_t)XCD_BAR_WORDS * 4);
    p.ssq = (float*)take((size_t)3 * NTOK * 4);
    p.nsa_ctr = (int*)take(256);
    p.h2 = (bf16_t*)((char*)p.proj + (size_t)NTOK * DFF * 2);
    if ((char*)p.h2 + (size_t)NTOK * DM * 2 > (char*)p.kc) { fprintf(stderr, "h2 overlay does not fit\n"); return; }
    if (off > ws_size) { fprintf(stderr, "workspace too small: need %zu have %zu\n", off, ws_size); return; }
#if MEGA
    constexpr int kDynLds = LDS_BYTES + 64;
    hipMemsetAsync(p.bar, 0, (size_t)XCD_BAR_WORDS * 4, stream);
    hipFuncSetAttribute((const void*)mega_kernel, hipFuncAttributeMaxDynamicSharedMemorySize, kDynLds);
    int dev = 0, cus = 0, per_cu = 0;
    hipGetDevice(&dev);
    hipDeviceGetAttribute(&cus, hipDeviceAttributeMultiprocessorCount, dev);
    hipOccupancyMaxActiveBlocksPerMultiprocessor(&per_cu, mega_kernel, 256, kDynLds);
    if (per_cu > 2) per_cu = 2;
    int grid = cus * per_cu;
    void* args[] = {&p};
    hipError_t e = hipLaunchCooperativeKernel((void*)mega_kernel, dim3(grid), dim3(256), args, kDynLds, stream);
    if (e != hipSuccess) fprintf(stderr, "cooperative launch failed: %s (grid %d)\n", hipGetErrorString(e), grid);
#endif
}
```

```cpp
#include <hip/hip_runtime.h>
#include <hip/hip_cooperative_groups.h>
#include <cstdio>
#include <cstdint>
namespace cg = cooperative_groups;

#ifndef MEGA
#define MEGA 1
#endif

typedef unsigned short bf16_t;
typedef short bf16x8 __attribute__((ext_vector_type(8)));
typedef float f32x4 __attribute__((ext_vector_type(4)));
typedef unsigned u32x4 __attribute__((ext_vector_type(4)));
typedef unsigned u32x2 __attribute__((ext_vector_type(2)));
#define DI __device__ __forceinline__

constexpr int T_ = 16384, NB = 2, NTOK = 32768, DM = 1024, DINO = 2974, DINP = 3072, DFF = 4096;
constexpr int C_QKV = 0, C_Z = 1152, C_BA = 1536, C_QB = 1600, C_KV = 1984, C_GATE = 2752, C_UC = 2816;
constexpr int LDS_BYTES = 73728;
constexpr int REC = 40960;
constexpr int NSCAN = 12;

struct Params {
    const float* x; const float* norm_mix; const float* w_in; const float* conv_w; const float* a_log; const float* dt_bias;
    const float* gdn_norm; const float* q_norm; const float* k_norm; const float* cmp_pos; const float* cmp_w1; const float* cmp_w2;
    const float* pool_w; const float* pool_scale; const float* w_out; const float* norm_ffn; const float* w_ffn1; const float* w_ffn2;
    float* out;
    bf16_t* wb_in; bf16_t* wb_out; bf16_t* wb_f1; bf16_t* wb_f2; bf16_t* wb_c1; bf16_t* wb_c2;
    bf16_t* hy;
    bf16_t* proj;
    bf16_t* hid;
    char* rec;
    float* glast;
    float* side;
    bf16_t* qn;
    bf16_t* ksn; bf16_t* kwn;
    bf16_t* vst; bf16_t* vwt;
    bf16_t* kc;
    bf16_t* vct;
    unsigned* bar;
    bf16_t* h2;
    float* ssq;
    int* nsa_ctr;
};

DI int tid_() { int t = threadIdx.x; asm volatile("" : "+v"(t)); return t; }
DI float bf2f(bf16_t v) { return __uint_as_float(((unsigned)v) << 16); }
DI bf16_t f2bf(float x) { unsigned u = __float_as_uint(x); u += 0x7fffu + ((u >> 16) & 1u); return (bf16_t)(u >> 16); }
typedef __bf16 bf16x2_t __attribute__((ext_vector_type(2)));
typedef float f32x2 __attribute__((ext_vector_type(2)));
DI unsigned pk2(float lo, float hi) { f32x2 v = {lo, hi}; bf16x2_t r = __builtin_convertvector(v, bf16x2_t); return __builtin_bit_cast(unsigned, r); }
DI f32x4 mfma(bf16x8 a, bf16x8 b, f32x4 c) { return __builtin_amdgcn_mfma_f32_16x16x32_bf16(a, b, c, 0, 0, 0); }
DI bf16x8 pack2(f32x4 a, f32x4 b) {
    u32x4 r; r[0] = pk2(a[0], a[1]); r[1] = pk2(a[2], a[3]); r[2] = pk2(b[0], b[1]); r[3] = pk2(b[2], b[3]);
    return __builtin_bit_cast(bf16x8, r);
}
DI int PERM(int p) { return (p & ~31) + 16 * ((p >> 2) & 1) + 4 * ((p >> 3) & 3) + (p & 3); }
DI int PINV(int s) { return (s & ~31) | ((s & 12) << 1) | ((s & 16) >> 2) | (s & 3); }
DI float sigmoidf_(float x) { return 1.f / (1.f + __expf(-x)); }
DI float siluf_(float x) { return x / (1.f + __expf(-x)); }

DI void cvt_job(const float* src, bf16_t* dst, int K, int Nn, int NnPad, int remap, char* smem) {
    float* tile = (float*)smem;
    const int tid = tid_();
    const int nkt = K / 64, items = nkt * (NnPad / 64);
    for (int it = blockIdx.x; it < items; it += gridDim.x) {
        const int kt = it % nkt, nt = it / nkt;
        {
            const int c = tid & 63, r = tid >> 6;
            const int nn = nt * 64 + c;
            int no = nn;
            if (remap) { no = nn < 1548 ? nn : (nn < 1600 ? -1 : (nn < 2770 ? nn - 52 : (nn < 2816 ? -1 : nn - 98))); }
            if (no >= Nn) no = -1;
#pragma unroll
            for (int i = 0; i < 16; ++i) {
                const int k = r + 4 * i;
                tile[k * 65 + c] = (no >= 0) ? src[(size_t)(kt * 64 + k) * Nn + no] : 0.f;
            }
        }
        __syncthreads();
        {
            const int nl = tid >> 2, part = tid & 3;
            u32x4 v0, v1;
#pragma unroll
            for (int j = 0; j < 4; ++j) {
                v0[j] = pk2(tile[(part * 16 + 2 * j) * 65 + nl], tile[(part * 16 + 2 * j + 1) * 65 + nl]);
                v1[j] = pk2(tile[(part * 16 + 8 + 2 * j) * 65 + nl], tile[(part * 16 + 8 + 2 * j + 1) * 65 + nl]);
            }
            bf16_t* d = dst + (size_t)(nt * 64 + nl) * K + kt * 64 + part * 16;
            *(u32x4*)d = v0; *(u32x4*)(d + 8) = v1;
        }
        __syncthreads();
    }
}
DI void phase_convert(const Params& p, char* smem) {
    for (int i = blockIdx.x * 256 + tid_(); i < 3 * NTOK; i += gridDim.x * 256) p.ssq[i] = 0.f;
    if (blockIdx.x == 0 && tid_() < 8) p.nsa_ctr[tid_()] = 0;
    for (int l = 0; l < 2; ++l) {
        cvt_job(p.w_in + (size_t)l * DM * DINO, p.wb_in + (size_t)l * DINP * DM, DM, DINO, DINP, 1, smem);
        cvt_job(p.w_out + (size_t)l * DM * DM, p.wb_out + (size_t)l * DM * DM, DM, DM, DM, 0, smem);
        cvt_job(p.w_ffn1 + (size_t)l * DM * DFF, p.wb_f1 + (size_t)l * DFF * DM, DM, DFF, DFF, 0, smem);
        cvt_job(p.w_ffn2 + (size_t)l * DFF * DM, p.wb_f2 + (size_t)l * DM * DFF, DFF, DM, DM, 0, smem);
        for (int kv = 0; kv < 2; ++kv) {
            cvt_job(p.cmp_w1 + (size_t)(l * 2 + kv) * 2048 * 256, p.wb_c1 + (size_t)(l * 2 + kv) * 256 * 2048, 2048, 256, 256, 0, smem);
            cvt_job(p.cmp_w2 + (size_t)(l * 2 + kv) * 256 * 64, p.wb_c2 + (size_t)(l * 2 + kv) * 64 * 256, 256, 64, 64, 0, smem);
        }
    }
}

DI void phase_rmsnorm(const float* X, const float* g, bf16_t* H) {
    const int lane = tid_() & 63, wave = __builtin_amdgcn_readfirstlane(tid_() >> 6);
    for (int row = blockIdx.x * 4 + wave; row < NTOK; row += gridDim.x * 4) {
        const float* xr = X + (size_t)row * DM;
        f32x4 v[4]; float ss = 0.f;
#pragma unroll
        for (int i = 0; i < 4; ++i) { v[i] = *(const f32x4*)(xr + i * 256 + lane * 4); ss += v[i][0] * v[i][0] + v[i][1] * v[i][1] + v[i][2] * v[i][2] + v[i][3] * v[i][3]; }
#pragma unroll
        for (int o = 32; o >= 1; o >>= 1) ss += __shfl_xor(ss, o);
        const float r = rsqrtf(ss * (1.f / DM) + 1e-6f);
#pragma unroll
        for (int i = 0; i < 4; ++i) {
            const f32x4 gg = *(const f32x4*)(g + i * 256 + lane * 4);
            u32x2 o2; o2[0] = pk2(v[i][0] * r * gg[0], v[i][1] * r * gg[1]); o2[1] = pk2(v[i][2] * r * gg[2], v[i][3] * r * gg[3]);
            *(u32x2*)(H + (size_t)row * DM + i * 256 + lane * 4) = o2;
        }
    }
}

template <int EPI>
DI void gemm_phase(const bf16_t* __restrict__ A, const bf16_t* __restrict__ Bt, int M, int Nn, int K,
                   bf16_t* outb, float* side, const float* xin, float* xout, char* smem,
                   const float* rs_in = nullptr, bf16_t* hb = nullptr, const float* gn = nullptr, float* ssq_out = nullptr) {
    const int tid = tid_(), lane = tid & 63, wave = tid >> 6, wr = wave >> 1, wc = wave & 1, fr = lane & 15, fq = lane >> 4;
    const int nNt = Nn / 256, nTiles = (M / 128) * nNt, nk = K / 32;
    bf16_t* sA = (bf16_t*)smem;
    bf16_t* sB = sA + 2 * 128 * 40;
    const int lrow = tid >> 2, lcc = tid & 3;
    const int xcd = blockIdx.x & 7, nbx = gridDim.x >> 3, nNb = nNt >> 2, perX = (nTiles >> 3);
    const int lrowp = 32 * (lrow >> 5) + 8 * (((lrow & 31) & 15) >> 2) + 4 * ((lrow & 31) >> 4) + (lrow & 3);
    auto tile_of = [&](int idx, int& mt_, int& nt_) { const int q = idx >> 6, r = idx & 63; mt_ = ((q / nNb) * 16 + (r >> 2)) * 8 + xcd; nt_ = (q % nNb) * 4 + (r & 3); };
    u32x4 ra[2], rb[4];
#define G_LOAD(PA, PB, STEP) do { _Pragma("unroll") for (int i_ = 0; i_ < 2; ++i_) ra[i_] = *(const u32x4*)((PA) + (size_t)(64 * i_) * K + (STEP) * 32); \
        _Pragma("unroll") for (int i_ = 0; i_ < 4; ++i_) rb[i_] = *(const u32x4*)((PB) + (size_t)(64 * i_) * K + (STEP) * 32); } while (0)
#define G_STORE(BUF) do { _Pragma("unroll") for (int i_ = 0; i_ < 2; ++i_) *(u32x4*)(sA + (BUF) * 128 * 40 + (lrow + 64 * i_) * 40 + lcc * 8) = ra[i_]; \
        _Pragma("unroll") for (int i_ = 0; i_ < 4; ++i_) *(u32x4*)(sB + (BUF) * 256 * 40 + (lrow + 64 * i_) * 40 + lcc * 8) = rb[i_]; } while (0)
    const int idx0 = blockIdx.x >> 3;
    if (idx0 < perX) {
        int mt0, nt0; tile_of(idx0, mt0, nt0);
        const bf16_t* A0 = A + (size_t)(mt0 * 128 + lrow) * K + lcc * 8;
        const bf16_t* B0 = Bt + (size_t)(nt0 * 256 + lrowp) * K + lcc * 8;
        G_LOAD(A0, B0, 0);
        G_STORE(0);
        G_LOAD(A0, B0, 1);
        __syncthreads();
    }
    for (int idx = idx0; idx < perX; idx += nbx) {
        int mt, nt; tile_of(idx, mt, nt);
        int mtn, ntn; tile_of(idx + nbx < perX ? idx + nbx : idx, mtn, ntn);
        const bf16_t* Ag = A + (size_t)(mt * 128 + lrow) * K + lcc * 8;
        const bf16_t* Bg = Bt + (size_t)(nt * 256 + lrowp) * K + lcc * 8;
        const bf16_t* An = A + (size_t)(mtn * 128 + lrow) * K + lcc * 8;
        const bf16_t* Bn = Bt + (size_t)(ntn * 256 + lrowp) * K + lcc * 8;
        f32x4 acc[4][8];
#pragma unroll
        for (int i = 0; i < 4; ++i)
#pragma unroll
            for (int j = 0; j < 8; ++j) {
                if (EPI == 2)
                    acc[i][j] = *(const f32x4*)(xin + (size_t)(mt * 128 + wr * 64 + i * 16 + fr) * Nn + nt * 256 + wc * 128 + 32 * (j >> 1) + 8 * fq + 4 * (j & 1));
                else acc[i][j] = (f32x4){0.f, 0.f, 0.f, 0.f};
            }
        for (int kt = 0; kt < nk; ++kt) {
            const int buf = kt & 1;
            const bf16_t* a_ = sA + buf * 128 * 40 + (wr * 64 + fr) * 40 + fq * 8;
            const bf16_t* b_ = sB + buf * 256 * 40 + (wc * 128 + fr) * 40 + fq * 8;
            bf16x8 af[4];
#pragma unroll
            for (int i = 0; i < 4; ++i) af[i] = *(const bf16x8*)(a_ + i * 16 * 40);
#pragma unroll
            for (int jh = 0; jh < 2; ++jh) {
                bf16x8 bfr[4];
#pragma unroll
                for (int j = 0; j < 4; ++j) bfr[j] = *(const bf16x8*)(b_ + (jh * 4 + j) * 16 * 40);
#pragma unroll
                for (int i = 0; i < 4; ++i)
#pragma unroll
                    for (int j = 0; j < 4; ++j) acc[i][jh * 4 + j] = mfma(bfr[j], af[i], acc[i][jh * 4 + j]);
            }
            G_STORE(buf ^ 1);
            {
                const bool cur = kt + 2 < nk;
                const bf16_t* pa = cur ? Ag : An; const bf16_t* pb = cur ? Bg : Bn;
                const int st = cur ? kt + 2 : kt + 2 - nk;
                G_LOAD(pa, pb, st);
            }
            __syncthreads();
        }
#undef G_LOAD
#undef G_STORE
#pragma unroll
        for (int i = 0; i < 4; ++i) {
            const int m = mt * 128 + wr * 64 + i * 16 + fr;
            float rsc = 1.f;
            if (EPI != 2 && rs_in) rsc = rsqrtf(rs_in[m] * (1.f / DM) + 1e-6f);
            float sq = 0.f;
#pragma unroll
            for (int jp = 0; jp < 4; ++jp) {
                const int n0 = nt * 256 + wc * 128 + 32 * jp + 8 * fq;
                f32x4 v0 = acc[i][2 * jp] * rsc, v1 = acc[i][2 * jp + 1] * rsc;
                if (EPI == 0) {
                    u32x4 o4; o4[0] = pk2(v0[0], v0[1]); o4[1] = pk2(v0[2], v0[3]); o4[2] = pk2(v1[0], v1[1]); o4[3] = pk2(v1[2], v1[3]);
                    *(u32x4*)(outb + (size_t)m * Nn + n0) = o4;
                    if (n0 >= C_BA && n0 < C_BA + 12) *(f32x4*)(side + (size_t)m * 12 + (n0 - C_BA)) = v0;
                    if (n0 + 4 >= C_BA && n0 + 4 < C_BA + 12) *(f32x4*)(side + (size_t)m * 12 + (n0 + 4 - C_BA)) = v1;
                } else if (EPI == 1) {
#pragma unroll
                    for (int e = 0; e < 4; ++e) { const float r0 = fmaxf(v0[e], 0.f), r1 = fmaxf(v1[e], 0.f); v0[e] = r0 * r0; v1[e] = r1 * r1; }
                    u32x4 o4; o4[0] = pk2(v0[0], v0[1]); o4[1] = pk2(v0[2], v0[3]); o4[2] = pk2(v1[0], v1[1]); o4[3] = pk2(v1[2], v1[3]);
                    *(u32x4*)(outb + (size_t)m * Nn + n0) = o4;
                } else {
                    *(f32x4*)(xout + (size_t)m * Nn + n0) = v0;
                    *(f32x4*)(xout + (size_t)m * Nn + n0 + 4) = v1;
                    if (hb) {
                        const f32x4 g0 = *(const f32x4*)(gn + n0), g1 = *(const f32x4*)(gn + n0 + 4);
                        u32x4 o4; o4[0] = pk2(v0[0] * g0[0], v0[1] * g0[1]); o4[1] = pk2(v0[2] * g0[2], v0[3] * g0[3]);
                        o4[2] = pk2(v1[0] * g1[0], v1[1] * g1[1]); o4[3] = pk2(v1[2] * g1[2], v1[3] * g1[3]);
                        *(u32x4*)(hb + (size_t)m * Nn + n0) = o4;
                        sq += v0[0] * v0[0] + v0[1] * v0[1] + v0[2] * v0[2] + v0[3] * v0[3] + v1[0] * v1[0] + v1[1] * v1[1] + v1[2] * v1[2] + v1[3] * v1[3];
                    }
                }
            }
            if (EPI == 2 && hb) {
                sq += __shfl_xor(sq, 16); sq += __shfl_xor(sq, 32);
                if (fq == 0) atomicAdd(ssq_out + m, sq);
            }
        }
    }
}

DI void phase_gdn_prep(const Params& p, int l, char* smem) {
    float* sq = (float*)smem; float* sk = sq + 64 * 65; float* sv = sk + 64 * 65; float* sL = sv + 64 * 65;
    float* sgc = sL + 64 * 64; float* sbeta = sgc + 64;
    const int tid = tid_(), lane = tid & 63;
    const float* cw = p.conv_w + (size_t)l * 4 * 1152;
    u32x4 raw[9]; float pbb = 0.f, paa = 0.f;
    auto prefetch = [&](int it) {
        const int chunk_ = it & 255, bh_ = it >> 8, h_ = bh_ % 6, b_ = bh_ / 6;
        const int tb0_ = chunk_ * 64; const size_t row0_ = (size_t)b_ * T_ + tb0_;
#pragma unroll
        for (int part = 0; part < 3; ++part)
#pragma unroll
            for (int k = 0; k < 3; ++k) {
                const int c = tid + 256 * k, r = c >> 3, cc = c & 7;
                const bool ok = c < 67 * 8 && tb0_ + r - 3 >= 0;
                const bf16_t* src = p.proj + (row0_ + (ok ? r : 3) - 3) * DINP + part * 384 + h_ * 64 + cc * 8;
                const u32x4 v = *(const u32x4*)src;
                raw[part * 3 + k] = ok ? v : (u32x4){0u, 0u, 0u, 0u};
            }
        if (tid < 64) { pbb = p.side[(row0_ + tid) * 12 + h_]; paa = p.side[(row0_ + tid) * 12 + 6 + h_]; }
    };
    if ((int)blockIdx.x < 3072) prefetch(blockIdx.x);
    for (int item = blockIdx.x; item < 3072; item += gridDim.x) {
        const int chunk = item & 255, bh = item >> 8, h = bh % 6, b = bh / 6;
        const int tb0 = chunk * 64; const size_t row0 = (size_t)b * T_ + tb0;
        char* rec = p.rec + (size_t)item * REC;
        {
            bf16_t* sraw = (bf16_t*)sL;
            const int ch = tid & 63, tq = tid >> 6;
#pragma unroll
            for (int part = 0; part < 3; ++part) {
#pragma unroll
                for (int k = 0; k < 3; ++k) { const int c = tid + 256 * k; if (c < 67 * 8) *(u32x4*)(sraw + c * 8) = raw[part * 3 + k]; }
                __syncthreads();
                const int col = part * 384 + h * 64 + ch;
                const float w0 = cw[col], w1 = cw[1152 + col], w2 = cw[2 * 1152 + col], w3 = cw[3 * 1152 + col];
                float* dst = part == 0 ? sq : (part == 1 ? sk : sv);
#pragma unroll
                for (int i = 0; i < 16; ++i) {
                    const int t = tq + 4 * i;
                    const float x0 = bf2f(sraw[(t + 0) * 64 + ch]), x1 = bf2f(sraw[(t + 1) * 64 + ch]);
                    const float x2 = bf2f(sraw[(t + 2) * 64 + ch]), x3 = bf2f(sraw[(t + 3) * 64 + ch]);
                    const float a = x0 * w0 + x1 * w1 + x2 * w2 + x3 * w3;
                    dst[t * 65 + ch] = siluf_(a);
                }
                __syncthreads();
            }
        }
        const float bb = pbb, aa = paa;
        if (tid < 64) {
            const float xx = aa + p.dt_bias[l * 6 + h];
            const float sp = xx > 20.f ? xx : log1pf(expf(xx));
            float g = -expf(p.a_log[l * 6 + h]) * sp;
#pragma unroll
            for (int off = 1; off < 64; off <<= 1) { const float v = __shfl_up(g, off); if (lane >= off) g += v; }
            sgc[tid] = g; sbeta[tid] = 1.f / (1.f + expf(-bb));
            if (tid == 63) p.glast[item] = expf(g);
        }
        __syncthreads();
        {
            const int t = tid >> 2, part = tid & 3;
            float s1 = 0.f, s2 = 0.f;
#pragma unroll
            for (int j = 0; j < 16; ++j) { const float a = sq[t * 65 + part * 16 + j], c = sk[t * 65 + part * 16 + j]; s1 += a * a; s2 += c * c; }
            s1 += __shfl_xor(s1, 1); s1 += __shfl_xor(s1, 2); s2 += __shfl_xor(s2, 1); s2 += __shfl_xor(s2, 2);
            const float r1 = rsqrtf(s1 + 1e-6f) * 0.125f, r2 = rsqrtf(s2 + 1e-6f);
#pragma unroll
            for (int j = 0; j < 16; ++j) { sq[t * 65 + part * 16 + j] *= r1; sk[t * 65 + part * 16 + j] *= r2; }
        }
        __syncthreads();
        f32x4 kkt[4], qkt[4];
        {
            char* qb = (char*)sL; char* kb = qb + 8192;
            {
                const int t = tid >> 2, part = tid & 3, sw = (t >> 1) & 7;
                u32x4 a0, a1, c0, c1;
#pragma unroll
                for (int j = 0; j < 4; ++j) {
                    a0[j] = pk2(sq[t * 65 + part * 16 + 2 * j], sq[t * 65 + part * 16 + 2 * j + 1]); a1[j] = pk2(sq[t * 65 + part * 16 + 8 + 2 * j], sq[t * 65 + part * 16 + 9 + 2 * j]);
                    c0[j] = pk2(sk[t * 65 + part * 16 + 2 * j], sk[t * 65 + part * 16 + 2 * j + 1]); c1[j] = pk2(sk[t * 65 + part * 16 + 8 + 2 * j], sk[t * 65 + part * 16 + 9 + 2 * j]);
                }
                *(u32x4*)(qb + t * 128 + (((part * 2) ^ sw) << 4)) = a0; *(u32x4*)(qb + t * 128 + (((part * 2 + 1) ^ sw) << 4)) = a1;
                *(u32x4*)(kb + t * 128 + (((part * 2) ^ sw) << 4)) = c0; *(u32x4*)(kb + t * 128 + (((part * 2 + 1) ^ sw) << 4)) = c1;
            }
            __syncthreads();
            const int wv = tid >> 6, fr = lane & 15, fq = lane >> 4;
            const int rc = wv * 16 + fr, swc = (rc >> 1) & 7;
            bf16x8 kB[2], qB[2];
#pragma unroll
            for (int ks = 0; ks < 2; ++ks) {
                kB[ks] = *(const bf16x8*)(kb + rc * 128 + (((ks * 4 + fq) ^ swc) << 4));
                qB[ks] = *(const bf16x8*)(qb + rc * 128 + (((ks * 4 + fq) ^ swc) << 4));
            }
#pragma unroll
            for (int st = 0; st < 4; ++st) {
                const int rs = st * 16 + fr, sws = (rs >> 1) & 7;
                const bf16x8 kA0 = *(const bf16x8*)(kb + rs * 128 + (((0 + fq) ^ sws) << 4)), kA1 = *(const bf16x8*)(kb + rs * 128 + (((4 + fq) ^ sws) << 4));
                f32x4 z = (f32x4){0.f, 0.f, 0.f, 0.f};
                kkt[st] = mfma(kA1, kB[1], mfma(kA0, kB[0], z));
                qkt[st] = mfma(kA1, qB[1], mfma(kA0, qB[0], z));
            }
        }
        {
            const int r = tid >> 2, part = tid & 3;
            const float eg = __expf(sgc[r]);
            u32x4 v0, v1, w0, w1;
#pragma unroll
            for (int j = 0; j < 8; ++j) {
                const int p0 = part * 16 + 2 * j, p1 = p0 + 1;
                const unsigned a = pk2(sq[r * 65 + PERM(p0)] * eg, sq[r * 65 + PERM(p1)] * eg);
                const int c0 = PERM(p0), c1 = PERM(p1);
                const unsigned c = pk2(sk[c0 * 65 + r] * __expf(sgc[63] - sgc[c0]), sk[c1 * 65 + r] * __expf(sgc[63] - sgc[c1]));
                if (j < 4) { v0[j] = a; w0[j] = c; } else { v1[j - 4] = a; w1[j - 4] = c; }
            }
            *(u32x4*)(rec + 8192 + (r * 64 + part * 16) * 2) = v0; *(u32x4*)(rec + 8192 + (r * 64 + part * 16 + 8) * 2) = v1;
            *(u32x4*)(rec + 24576 + (r * 64 + part * 16) * 2) = w0; *(u32x4*)(rec + 24576 + (r * 64 + part * 16 + 8) * 2) = w1;
        }
        __syncthreads();
        {
            const int wv = tid >> 6, fr = lane & 15, fq = lane >> 4;
            const int c = wv * 16 + fr;
            const float gcc = sgc[c], bc = sbeta[c];
#pragma unroll
            for (int st = 0; st < 4; ++st) {
                const int s0 = st * 16 + fq * 4;
                f32x4 lv; float qv[4];
#pragma unroll
                for (int ii = 0; ii < 4; ++ii) {
                    const int s_ = s0 + ii;
                    const float e = (s_ <= c) ? __expf(gcc - sgc[s_]) : 0.f;
                    lv[ii] = (s_ < c) ? bc * kkt[st][ii] * e : 0.f;
                    qv[ii] = qkt[st][ii] * e;
                }
                *(f32x4*)(sL + c * 64 + s0) = lv;
                u32x2 o2; o2[0] = pk2(qv[0], qv[1]); o2[1] = pk2(qv[2], qv[3]);
                *(u32x2*)(rec + 16384 + (c * 64 + PINV(s0)) * 2) = o2;
            }
        }
        {
            const int t = tid >> 2, part = tid & 3;
            const float bt = sbeta[t], be = bt * __expf(sgc[t]);
#pragma unroll
            for (int j = 0; j < 16; ++j) { sv[t * 65 + part * 16 + j] *= bt; sk[t * 65 + part * 16 + j] *= be; }
        }
        __syncthreads();
        { const int nxt = item + (int)gridDim.x; prefetch(nxt < 3072 ? nxt : item); }
        for (int rb = 0; rb < 4; ++rb) {
            if (rb > 0) {
                const int j = tid & 127, rh = tid >> 7;
                float* X = (j < 64) ? sv : sk; const int col = j & 63;
                const int r0 = rb * 16 + rh * 8;
                float a[8];
#pragma unroll
                for (int i = 0; i < 8; ++i) a[i] = 0.f;
                for (int s4 = 0; s4 < rb * 16; s4 += 4) {
                    const float x0 = X[(s4 + 0) * 65 + col], x1 = X[(s4 + 1) * 65 + col], x2 = X[(s4 + 2) * 65 + col], x3 = X[(s4 + 3) * 65 + col];
#pragma unroll
                    for (int i = 0; i < 8; ++i) {
                        const f32x4 lv = *(const f32x4*)(sL + (r0 + i) * 64 + s4);
                        a[i] += lv[0] * x0 + lv[1] * x1 + lv[2] * x2 + lv[3] * x3;
                    }
                }
#pragma unroll
                for (int i = 0; i < 8; ++i) X[(r0 + i) * 65 + col] -= a[i];
                __syncthreads();
            }
            if (tid < 128) {
                float* X = (tid < 64) ? sv : sk; const int col = tid & 63;
                float x[16];
#pragma unroll
                for (int i = 0; i < 16; ++i) x[i] = X[(rb * 16 + i) * 65 + col];
#pragma unroll
                for (int i = 1; i < 16; ++i) {
                    const float* Lr = sL + (rb * 16 + i) * 64 + rb * 16;
                    float acc = x[i];
#pragma unroll
                    for (int s2 = 0; s2 < i; ++s2) acc -= Lr[s2] * x[s2];
                    x[i] = acc;
                }
#pragma unroll
                for (int i = 1; i < 16; ++i) X[(rb * 16 + i) * 65 + col] = x[i];
            }
            __syncthreads();
        }
        {
            const int r = tid >> 2, part = tid & 3;
            u32x4 v0, v1, w0, w1;
#pragma unroll
            for (int j = 0; j < 8; ++j) {
                const int p0 = part * 16 + 2 * j, p1 = p0 + 1;
                const unsigned a = pk2(sk[r * 65 + PERM(p0)], sk[r * 65 + PERM(p1)]);
                const unsigned c = pk2(sv[p0 * 65 + r], sv[p1 * 65 + r]);
                if (j < 4) { v0[j] = a; w0[j] = c; } else { v1[j - 4] = a; w1[j - 4] = c; }
            }
            *(u32x4*)(rec + (r * 64 + part * 16) * 2) = v0; *(u32x4*)(rec + (r * 64 + part * 16 + 8) * 2) = v1;
            *(u32x4*)(rec + 32768 + (r * 64 + part * 16) * 2) = w0; *(u32x4*)(rec + 32768 + (r * 64 + part * 16 + 8) * 2) = w1;
        }
        __syncthreads();
    }
}

DI void gdn_scan_block(const Params& p, int bh, char* smem) {
    __builtin_amdgcn_s_setprio(3);
    const int tid = tid_(), lane = tid & 63, wave = tid >> 6, fr = lane & 15, fq = lane >> 4;
    const int h = bh % 6, b = bh / 6, e0 = wave * 16;
    const char* recs = p.rec + (size_t)bh * 256 * REC;
    const float* glp = p.glast + bh * 256;
    const int uoff = 32768 + ((e0 + fr) * 64 + fq * 4) * 2;
    u32x4 r1[8]; u32x2 u1[4], uc[4]; float g1, gl;
#define SC_LOAD(R, U, G, CK) do { const char* rn_ = recs + (size_t)(CK) * REC; \
        _Pragma("unroll") for (int i_ = 0; i_ < 8; ++i_) R[i_] = *(const u32x4*)(rn_ + (tid + 256 * i_) * 16); \
        _Pragma("unroll") for (int c_ = 0; c_ < 4; ++c_) U[c_] = *(const u32x2*)(rn_ + uoff + c_ * 32); G = glp[CK]; } while (0)
#define SC_STORE(R, BUF) do { char* nb_ = smem + (BUF) * 36864; \
        _Pragma("unroll") for (int i_ = 0; i_ < 8; ++i_) { const int cid_ = tid + 256 * i_, mat_ = cid_ >> 9, row_ = (cid_ >> 3) & 63, cc_ = cid_ & 7; \
            *(u32x4*)(nb_ + mat_ * 9216 + row_ * 144 + cc_ * 16) = R[i_]; } } while (0)
    SC_LOAD(r1, u1, g1, 0);
    SC_STORE(r1, 0);
#pragma unroll
    for (int c = 0; c < 4; ++c) uc[c] = u1[c];
    gl = g1;
    SC_LOAD(r1, u1, g1, 1);
    __syncthreads();
    f32x4 S[4];
#pragma unroll
    for (int i = 0; i < 4; ++i) S[i] = (f32x4){0.f, 0.f, 0.f, 0.f};
    auto step = [&](const char* buf, int ck) {
        const char* fb = buf + fr * 144 + fq * 16;
        bf16x8 fa[4][2], fbq[4][2];
#pragma unroll
        for (int t = 0; t < 4; ++t) { fa[t][0] = *(const bf16x8*)(fb + t * 2304); fa[t][1] = *(const bf16x8*)(fb + t * 2304 + 64); }
#pragma unroll
        for (int t = 0; t < 4; ++t) { fbq[t][0] = *(const bf16x8*)(fb + 9216 + t * 2304); fbq[t][1] = *(const bf16x8*)(fb + 9216 + t * 2304 + 64); }
        const bf16x8 Sb0 = pack2(S[0], S[1]), Sb1 = pack2(S[2], S[3]);
        f32x4 vn[4];
#pragma unroll
        for (int ct = 0; ct < 4; ++ct) {
            f32x4 acc = (f32x4){0.f, 0.f, 0.f, 0.f};
            acc = mfma(fa[ct][0], Sb0, acc); acc = mfma(fa[ct][1], Sb1, acc);
            f32x4 u; u[0] = __uint_as_float(uc[ct][0] << 16); u[1] = __uint_as_float(uc[ct][0] & 0xffff0000u);
            u[2] = __uint_as_float(uc[ct][1] << 16); u[3] = __uint_as_float(uc[ct][1] & 0xffff0000u);
            vn[ct] = u - acc;
        }
#pragma unroll
        for (int t = 0; t < 4; ++t) { fa[t][0] = *(const bf16x8*)(fb + 18432 + t * 2304); fa[t][1] = *(const bf16x8*)(fb + 18432 + t * 2304 + 64); }
        f32x4 o[4];
#pragma unroll
        for (int ct = 0; ct < 4; ++ct) {
            f32x4 t = (f32x4){0.f, 0.f, 0.f, 0.f};
            t = mfma(fbq[ct][0], Sb0, t); t = mfma(fbq[ct][1], Sb1, t);
            o[ct] = t;
        }
#pragma unroll
        for (int t = 0; t < 4; ++t) { fbq[t][0] = *(const bf16x8*)(fb + 27648 + t * 2304); fbq[t][1] = *(const bf16x8*)(fb + 27648 + t * 2304 + 64); }
        const bf16x8 vb0 = pack2(vn[0], vn[1]), vb1 = pack2(vn[2], vn[3]);
        bf16_t* op = p.hy + ((size_t)b * T_ + ck * 64 + fq * 4) * DM + h * 64 + e0 + fr;
#pragma unroll
        for (int ct = 0; ct < 4; ++ct) {
            f32x4 t = o[ct];
            t = mfma(fa[ct][0], vb0, t); t = mfma(fa[ct][1], vb1, t);
#pragma unroll
            for (int ii = 0; ii < 4; ++ii) op[(size_t)(ct * 16 + ii) * DM] = f2bf(t[ii]);
        }
#pragma unroll
        for (int dt = 0; dt < 4; ++dt) {
            f32x4 sacc = S[dt] * gl;
            sacc = mfma(fbq[dt][0], vb0, sacc); sacc = mfma(fbq[dt][1], vb1, sacc);
            S[dt] = sacc;
        }
    };
    for (int ck = 0; ck < 256; ++ck) {
        step(smem + (ck & 1) * 36864, ck);
        SC_STORE(r1, (ck + 1) & 1);
#pragma unroll
        for (int c = 0; c < 4; ++c) uc[c] = u1[c];
        gl = g1;
        { const int cn = ck + 2 < 256 ? ck + 2 : 255; SC_LOAD(r1, u1, g1, cn); }
        __syncthreads();
    }
#undef SC_LOAD
#undef SC_STORE
    __builtin_amdgcn_s_setprio(0);
}

DI void phase_gdn_final(const Params& p, int l) {
    const int tid = tid_(), sub = tid & 7;
    f32x4 g0 = *(const f32x4*)(p.gdn_norm + l * 64 + sub * 8), g1 = *(const f32x4*)(p.gdn_norm + l * 64 + sub * 8 + 4);
    const int npair = NTOK * 6, stride = gridDim.x * 32;
    for (int pr0 = blockIdx.x * 32 + (tid >> 3); pr0 < npair; pr0 += stride * 4) {
        u32x4 ov[4], zv[4];
#pragma unroll
        for (int u = 0; u < 4; ++u) {
            const int pr = pr0 + u * stride; const int prc = pr < npair ? pr : pr0;
            const int n = prc / 6, h = prc - n * 6;
            ov[u] = *(const u32x4*)(p.hy + (size_t)n * DM + h * 64 + sub * 8);
            zv[u] = *(const u32x4*)(p.proj + (size_t)n * DINP + C_Z + h * 64 + sub * 8);
        }
#pragma unroll
        for (int u = 0; u < 4; ++u) {
            const int pr = pr0 + u * stride;
            float o[8], z[8];
#pragma unroll
            for (int e = 0; e < 4; ++e) {
                o[2 * e] = __uint_as_float(ov[u][e] << 16); o[2 * e + 1] = __uint_as_float(ov[u][e] & 0xffff0000u);
                z[2 * e] = __uint_as_float(zv[u][e] << 16); z[2 * e + 1] = __uint_as_float(zv[u][e] & 0xffff0000u);
            }
            float ss = 0.f;
#pragma unroll
            for (int e = 0; e < 8; ++e) ss += o[e] * o[e];
            ss += __shfl_xor(ss, 1); ss += __shfl_xor(ss, 2); ss += __shfl_xor(ss, 4);
            const float r = rsqrtf(ss * (1.f / 64.f) + 1e-6f);
            u32x4 w;
            w[0] = pk2(o[0] * r * g0[0] * siluf_(z[0]), o[1] * r * g0[1] * siluf_(z[1]));
            w[1] = pk2(o[2] * r * g0[2] * siluf_(z[2]), o[3] * r * g0[3] * siluf_(z[3]));
            w[2] = pk2(o[4] * r * g1[0] * siluf_(z[4]), o[5] * r * g1[1] * siluf_(z[5]));
            w[3] = pk2(o[6] * r * g1[2] * siluf_(z[6]), o[7] * r * g1[3] * siluf_(z[7]));
            if (pr < npair) { const int n = pr / 6, h = pr - n * 6; *(u32x4*)(p.hy + (size_t)n * DM + h * 64 + sub * 8) = w; }
        }
    }
}

DI void phase_nsa_prep(const Params& p, int l, char* smem) {
    bf16_t* tr = (bf16_t*)smem;
    const int tid = tid_(), t = tid >> 2, part = tid & 3;
    for (int item = blockIdx.x; item < NB * 2 * 256; item += gridDim.x) {
        const int blk = item & 255, kvh = (item >> 8) & 1, b = item >> 9;
        const size_t n = (size_t)b * T_ + blk * 64 + t;
        const bf16_t* pr = p.proj + n * DINP;
#pragma unroll
        for (int w = 0; w < 2; ++w) {
            const bf16_t* src = pr + C_KV + (w == 0 ? 256 : 512) + kvh * 64 + part * 16;
            const float* g = p.k_norm + (l * 3 + 1 + w) * 64 + part * 16;
            float v[16]; float ss = 0.f;
            { const u32x4 a0 = *(const u32x4*)src, a1 = *(const u32x4*)(src + 8);
#pragma unroll
              for (int j = 0; j < 4; ++j) { v[2 * j] = __uint_as_float(a0[j] << 16); v[2 * j + 1] = __uint_as_float(a0[j] & 0xffff0000u);
                                            v[8 + 2 * j] = __uint_as_float(a1[j] << 16); v[9 + 2 * j] = __uint_as_float(a1[j] & 0xffff0000u); } }
#pragma unroll
            for (int j = 0; j < 16; ++j) ss += v[j] * v[j];
            ss += __shfl_xor(ss, 1); ss += __shfl_xor(ss, 2);
            const float r = rsqrtf(ss * (1.f / 64.f) + 1e-6f);
            bf16_t* dst = (w == 0 ? p.ksn : p.kwn) + (((size_t)(b * 2 + kvh) * T_) + blk * 64 + t) * 64 + part * 16;
            u32x4 o0, o1;
#pragma unroll
            for (int j = 0; j < 4; ++j) { o0[j] = pk2(v[2 * j] * r * g[2 * j], v[2 * j + 1] * r * g[2 * j + 1]); o1[j] = pk2(v[8 + 2 * j] * r * g[8 + 2 * j], v[9 + 2 * j] * r * g[9 + 2 * j]); }
            *(u32x4*)dst = o0; *(u32x4*)(dst + 8) = o1;
        }
#pragma unroll
        for (int g3 = 0; g3 < 3; ++g3) {
            const int h = kvh * 3 + g3;
            const bf16_t* src = pr + C_QB + h * 64 + part * 16;
            const float* g = p.q_norm + l * 64 + part * 16;
            float v[16]; float ss = 0.f;
            { const u32x4 a0 = *(const u32x4*)src, a1 = *(const u32x4*)(src + 8);
#pragma unroll
              for (int j = 0; j < 4; ++j) { v[2 * j] = __uint_as_float(a0[j] << 16); v[2 * j + 1] = __uint_as_float(a0[j] & 0xffff0000u);
                                            v[8 + 2 * j] = __uint_as_float(a1[j] << 16); v[9 + 2 * j] = __uint_as_float(a1[j] & 0xffff0000u); } }
#pragma unroll
            for (int j = 0; j < 16; ++j) ss += v[j] * v[j];
            ss += __shfl_xor(ss, 1); ss += __shfl_xor(ss, 2);
            const float r = rsqrtf(ss * (1.f / 64.f) + 1e-6f) * (0.125f * 1.44269504089f);
            bf16_t* dst = p.qn + (n * 6 + h) * 64 + part * 16;
            u32x4 o0, o1;
#pragma unroll
            for (int j = 0; j < 4; ++j) { o0[j] = pk2(v[2 * j] * r * g[2 * j], v[2 * j + 1] * r * g[2 * j + 1]); o1[j] = pk2(v[8 + 2 * j] * r * g[8 + 2 * j], v[9 + 2 * j] * r * g[9 + 2 * j]); }
            *(u32x4*)dst = o0; *(u32x4*)(dst + 8) = o1;
        }
#pragma unroll
        for (int w = 0; w < 2; ++w) {
            const bf16_t* src = pr + C_KV + (w == 0 ? 384 : 640) + kvh * 64 + part * 16;
            { const u32x4 a0 = *(const u32x4*)src, a1 = *(const u32x4*)(src + 8);
#pragma unroll
              for (int j = 0; j < 4; ++j) {
                  tr[w * 64 * 66 + (part * 16 + 2 * j) * 66 + t] = (bf16_t)(a0[j] & 0xffffu); tr[w * 64 * 66 + (part * 16 + 2 * j + 1) * 66 + t] = (bf16_t)(a0[j] >> 16);
                  tr[w * 64 * 66 + (part * 16 + 8 + 2 * j) * 66 + t] = (bf16_t)(a1[j] & 0xffffu); tr[w * 64 * 66 + (part * 16 + 9 + 2 * j) * 66 + t] = (bf16_t)(a1[j] >> 16); } }
        }
        __syncthreads();
#pragma unroll
        for (int w = 0; w < 2; ++w) {
            const int d = t;
            u32x4 o0, o1;
#pragma unroll
            for (int j = 0; j < 8; ++j) {
                const int p0 = part * 16 + 2 * j;
                const unsigned a = (unsigned)tr[w * 64 * 66 + d * 66 + PERM(p0)] | ((unsigned)tr[w * 64 * 66 + d * 66 + PERM(p0 + 1)] << 16);
                if (j < 4) o0[j] = a; else o1[j - 4] = a;
            }
            bf16_t* dst = (w == 0 ? p.vst : p.vwt) + (((size_t)(b * 2 + kvh) * 256 + blk) * 64 + d) * 64 + part * 16;
            *(u32x4*)dst = o0; *(u32x4*)(dst + 8) = o1;
        }
        __syncthreads();
    }
}

DI void phase_compress(const Params& p, int l, char* smem) {
    const int tid = tid_(), lane = tid & 63, wave = __builtin_amdgcn_readfirstlane(tid >> 6), fr = lane & 15, fq = lane >> 4;
    float* red = (float*)smem;
    for (int item = blockIdx.x; item < 512; item += gridDim.x) {
        const int ci = item & 63, kvh = (item >> 6) & 1, b = (item >> 7) & 1, kv = item >> 8;
        const int c = ci * 16 + fr;
        const int cc = c > 1022 ? 1022 : c;
        const bf16_t* xr = p.proj + ((size_t)b * T_ + 16 * cc) * DINP + C_KV + kv * 128 + kvh * 64;
        const float* pos = p.cmp_pos + (size_t)(l * 2 + kv) * 32 * 64;
        const bf16_t* w1 = p.wb_c1 + (size_t)(l * 2 + kv) * 256 * 2048 + (size_t)(wave * 64 + fr) * 2048 + fq * 8;
        const bf16_t* w2 = p.wb_c2 + (size_t)(l * 2 + kv) * 64 * 256;
        f32x4 acc[4];
#pragma unroll
        for (int i = 0; i < 4; ++i) acc[i] = (f32x4){0.f, 0.f, 0.f, 0.f};
#pragma unroll 4
        for (int ks = 0; ks < 64; ++ks) {
            const int t = ks >> 1, db = (ks & 1) * 32 + fq * 8;
            const u32x4 xv = *(const u32x4*)(xr + (size_t)t * DINP + db);
            const f32x4 p0 = *(const f32x4*)(pos + t * 64 + db), p1 = *(const f32x4*)(pos + t * 64 + db + 4);
            bf16x8 wf[4];
#pragma unroll
            for (int i = 0; i < 4; ++i) wf[i] = *(const bf16x8*)(w1 + (size_t)i * 16 * 2048 + ks * 32);
            u32x4 xb;
            xb[0] = pk2(__uint_as_float(xv[0] << 16) + p0[0], __uint_as_float(xv[0] & 0xffff0000u) + p0[1]);
            xb[1] = pk2(__uint_as_float(xv[1] << 16) + p0[2], __uint_as_float(xv[1] & 0xffff0000u) + p0[3]);
            xb[2] = pk2(__uint_as_float(xv[2] << 16) + p1[0], __uint_as_float(xv[2] & 0xffff0000u) + p1[1]);
            xb[3] = pk2(__uint_as_float(xv[3] << 16) + p1[2], __uint_as_float(xv[3] & 0xffff0000u) + p1[3]);
            const bf16x8 bx = __builtin_bit_cast(bf16x8, xb);
#pragma unroll
            for (int i = 0; i < 4; ++i) acc[i] = mfma(wf[i], bx, acc[i]);
        }
        f32x4 o[4];
#pragma unroll
        for (int i = 0; i < 4; ++i) o[i] = (f32x4){0.f, 0.f, 0.f, 0.f};
#pragma unroll
        for (int kk = 0; kk < 2; ++kk) {
            const int k2 = wave * 2 + kk;
            f32x4 a = acc[2 * kk], c2 = acc[2 * kk + 1];
#pragma unroll
            for (int e = 0; e < 4; ++e) { a[e] = siluf_(a[e]); c2[e] = siluf_(c2[e]); }
            const bf16x8 hb = pack2(a, c2);
#pragma unroll
            for (int t2 = 0; t2 < 4; ++t2) {
                const bf16_t* wr = w2 + (size_t)(t2 * 16 + fr) * 256 + k2 * 32 + fq * 4;
                const u32x2 lo = *(const u32x2*)wr, hi = *(const u32x2*)(wr + 16);
                u32x4 wv; wv[0] = lo[0]; wv[1] = lo[1]; wv[2] = hi[0]; wv[3] = hi[1];
                o[t2] = mfma(__builtin_bit_cast(bf16x8, wv), hb, o[t2]);
            }
        }
#pragma unroll
        for (int t2 = 0; t2 < 4; ++t2)
#pragma unroll
            for (int e = 0; e < 4; ++e) red[(wave * 16 + t2 * 4 + e) * 64 + lane] = o[t2][e];
        __syncthreads();
        if (wave == 0) {
#pragma unroll
            for (int t2 = 0; t2 < 4; ++t2)
#pragma unroll
                for (int e = 0; e < 4; ++e) o[t2][e] += red[(16 + t2 * 4 + e) * 64 + lane] + red[(32 + t2 * 4 + e) * 64 + lane] + red[(48 + t2 * 4 + e) * 64 + lane];
            if (kv == 0) {
                float ss = 0.f;
#pragma unroll
                for (int t2 = 0; t2 < 4; ++t2)
#pragma unroll
                    for (int e = 0; e < 4; ++e) ss += o[t2][e] * o[t2][e];
                ss += __shfl_xor(ss, 16); ss += __shfl_xor(ss, 32);
                const float r = (c <= 1022) ? rsqrtf(ss * (1.f / 64.f) + 1e-6f) : 0.f;
                const float* g = p.k_norm + (l * 3 + 0) * 64;
#pragma unroll
                for (int t2 = 0; t2 < 4; ++t2) {
                    const int n2 = t2 * 16 + fq * 4;
                    u32x2 o2; o2[0] = pk2(o[t2][0] * r * g[n2], o[t2][1] * r * g[n2 + 1]); o2[1] = pk2(o[t2][2] * r * g[n2 + 2], o[t2][3] * r * g[n2 + 3]);
                    *(u32x2*)(p.kc + (((size_t)(b * 2 + kvh) * 1024) + c) * 64 + n2) = o2;
                }
            } else {
                const float z = (c <= 1022) ? 1.f : 0.f;
                bf16_t* dst = p.vct + ((size_t)(b * 2 + kvh) * 16 + (c >> 6)) * 4096 + PINV(c & 63);
#pragma unroll
                for (int t2 = 0; t2 < 4; ++t2)
#pragma unroll
                    for (int e = 0; e < 4; ++e) dst[(t2 * 16 + fq * 4 + e) * 64] = f2bf(o[t2][e] * z);
            }
        }
        __syncthreads();
    }
}

DI void phase_pool(const Params& p, int l, char* smem) {
    float* su = (float*)smem;
    float* sd = su + 79 * 64;
    float* sw = sd + 64 * 65;
    const int tid = tid_();
    u32x4 uv[3];
    auto prefetch = [&](int it) {
        const int gi_ = it & 3; const size_t n0_ = (size_t)(it >> 2) * 64; const int tb0_ = (int)(n0_ & (T_ - 1));
#pragma unroll
        for (int k = 0; k < 3; ++k) {
            const int c = tid + 256 * k, r = c >> 3, cc = c & 7;
            const bool ok = c < 79 * 8 && tb0_ - 15 + r >= 0;
            const u32x4 v = *(const u32x4*)(p.proj + (n0_ + (ok ? r : 15) - 15) * DINP + C_UC + gi_ * 64 + cc * 8);
            uv[k] = ok ? v : (u32x4){0u, 0u, 0u, 0u};
        }
    };
    int gi_loaded = -1;
    if ((int)blockIdx.x < 512 * 4) prefetch(blockIdx.x);
    for (int item = blockIdx.x; item < 512 * 4; item += gridDim.x) {
        const int gi = item & 3, tile = item >> 2;
        const int w = 2 << gi;
        const size_t n0 = (size_t)tile * 64; const int tb0 = (int)(n0 & (T_ - 1));
#pragma unroll
        for (int k = 0; k < 3; ++k) {
            const int c = tid + 256 * k;
            if (c < 79 * 8) {
                f32x4 lo, hi;
                lo[0] = __uint_as_float(uv[k][0] << 16); lo[1] = __uint_as_float(uv[k][0] & 0xffff0000u); lo[2] = __uint_as_float(uv[k][1] << 16); lo[3] = __uint_as_float(uv[k][1] & 0xffff0000u);
                hi[0] = __uint_as_float(uv[k][2] << 16); hi[1] = __uint_as_float(uv[k][2] & 0xffff0000u); hi[2] = __uint_as_float(uv[k][3] << 16); hi[3] = __uint_as_float(uv[k][3] & 0xffff0000u);
                *(f32x4*)(su + c * 8) = lo; *(f32x4*)(su + c * 8 + 4) = hi;
            }
        }
        if (gi != gi_loaded) {
#pragma unroll
            for (int k = 0; k < 4; ++k) *(f32x4*)(sw + (tid + 256 * k) * 4) = *(const f32x4*)(p.pool_w + ((size_t)(l * 4 + gi) * 64) * 64 + (tid + 256 * k) * 4);
            gi_loaded = gi;
        }
        { const int nxt = item + (int)gridDim.x; prefetch(nxt < 512 * 4 ? nxt : item); }
        __syncthreads();
        for (int i = tid; i < 4096; i += 256) {
            const int t = i >> 6, c = i & 63; const int tb = tb0 + t;
            float s_ = 0.f;
            for (int k = 0; k < w; ++k) s_ += su[(15 + t - k) * 64 + c];
            const float cnt = (float)(tb + 1 < w ? tb + 1 : w);
            sd[t * 65 + c] = s_ / cnt - su[(15 + t) * 64 + c];
        }
        __syncthreads();
        {
            const int t = tid >> 2, dq = (tid & 3) * 16;
            float acc[16];
#pragma unroll
            for (int j = 0; j < 16; ++j) acc[j] = 0.f;
            for (int c = 0; c < 64; ++c) {
                const float dv = sd[t * 65 + c];
#pragma unroll
                for (int j4 = 0; j4 < 4; ++j4) {
                    const f32x4 w4 = *(const f32x4*)(sw + c * 64 + dq + j4 * 4);
                    acc[j4 * 4 + 0] += dv * w4[0]; acc[j4 * 4 + 1] += dv * w4[1]; acc[j4 * 4 + 2] += dv * w4[2]; acc[j4 * 4 + 3] += dv * w4[3];
                }
            }
            const float* sc = p.pool_scale + l * 256 + gi * 64 + dq;
            u32x4 o0, o1;
#pragma unroll
            for (int j = 0; j < 4; ++j) { o0[j] = pk2(acc[2 * j] * sc[2 * j], acc[2 * j + 1] * sc[2 * j + 1]); o1[j] = pk2(acc[8 + 2 * j] * sc[8 + 2 * j], acc[9 + 2 * j] * sc[9 + 2 * j]); }
            bf16_t* dst = p.hy + (n0 + t) * DM + 768 + gi * 64 + dq;
            *(u32x4*)dst = o0; *(u32x4*)(dst + 8) = o1;
        }
        __syncthreads();
    }
}

DI void st_tile(const bf16_t* Kp, const bf16x8 (&qf)[2], int fr, int fq, f32x4 (&st)[4]) {
#pragma unroll
    for (int k4 = 0; k4 < 4; ++k4) {
        const bf16_t* kr = Kp + (k4 * 16 + fr) * 64 + fq * 8;
        f32x4 a = (f32x4){0.f, 0.f, 0.f, 0.f};
        a = mfma(*(const bf16x8*)kr, qf[0], a); a = mfma(*(const bf16x8*)(kr + 32), qf[1], a);
        st[k4] = a;
    }
}
DI void pv_tile(const bf16_t* VTp, const f32x4 (&pt)[4], int fr, int fq, f32x4 (&o)[4]) {
    const bf16x8 pb0 = pack2(pt[0], pt[1]), pb1 = pack2(pt[2], pt[3]);
#pragma unroll
    for (int dt = 0; dt < 4; ++dt) {
        const bf16_t* vr = VTp + (dt * 16 + fr) * 64 + fq * 8;
        o[dt] = mfma(*(const bf16x8*)vr, pb0, o[dt]); o[dt] = mfma(*(const bf16x8*)(vr + 32), pb1, o[dt]);
    }
}
template <bool FULL = false>
DI void online_step(f32x4 (&st)[4], unsigned vmask, float& m, float& lsum, f32x4 (&o)[4]) {
    float tmax = -1e30f;
#pragma unroll
    for (int k4 = 0; k4 < 4; ++k4)
#pragma unroll
        for (int ii = 0; ii < 4; ++ii) if (FULL || (vmask & (1u << (k4 * 4 + ii)))) tmax = fmaxf(tmax, st[k4][ii]);
    tmax = fmaxf(tmax, __shfl_xor(tmax, 16)); tmax = fmaxf(tmax, __shfl_xor(tmax, 32));
    const float mn = fmaxf(m, tmax), alpha = __builtin_amdgcn_exp2f(m - mn);
    m = mn;
    float ps = 0.f;
#pragma unroll
    for (int k4 = 0; k4 < 4; ++k4)
#pragma unroll
        for (int ii = 0; ii < 4; ++ii) { const float pv = (FULL || (vmask & (1u << (k4 * 4 + ii)))) ? __builtin_amdgcn_exp2f(st[k4][ii] - mn) : 0.f; st[k4][ii] = pv; ps += pv; }
    lsum = lsum * alpha + ps;
#pragma unroll
    for (int dt = 0; dt < 4; ++dt) o[dt] *= alpha;
}

DI void ldfrag(const bf16_t* P, int fr, int fq, bf16x8 (&f)[4][2]) {
#pragma unroll
    for (int k4 = 0; k4 < 4; ++k4) { f[k4][0] = *(const bf16x8*)(P + (k4 * 16 + fr) * 64 + fq * 8); f[k4][1] = *(const bf16x8*)(P + (k4 * 16 + fr) * 64 + 32 + fq * 8); }
}
DI void st_from(const bf16x8 (&kf)[4][2], const bf16x8 (&qf)[2], f32x4 (&st)[4], float c0 = 0.f) {
#pragma unroll
    for (int k4 = 0; k4 < 4; ++k4) { f32x4 a = (f32x4){c0, c0, c0, c0}; a = mfma(kf[k4][0], qf[0], a); a = mfma(kf[k4][1], qf[1], a); st[k4] = a; }
}
DI void pv_from(const bf16x8 (&vf)[4][2], const f32x4 (&pt)[4], f32x4 (&o)[4]) {
    const bf16x8 pb0 = pack2(pt[0], pt[1]), pb1 = pack2(pt[2], pt[3]);
#pragma unroll
    for (int dt = 0; dt < 4; ++dt) { o[dt] = mfma(vf[dt][0], pb0, o[dt]); o[dt] = mfma(vf[dt][1], pb1, o[dt]); }
}
template <bool FULL = false>
DI void stats_step(const f32x4 (&st)[4], unsigned vmask, float& m, float& lsum) {
    float tmax = -1e30f;
#pragma unroll
    for (int k4 = 0; k4 < 4; ++k4)
#pragma unroll
        for (int ii = 0; ii < 4; ++ii) if (FULL || (vmask & (1u << (k4 * 4 + ii)))) tmax = fmaxf(tmax, st[k4][ii]);
    tmax = fmaxf(tmax, __shfl_xor(tmax, 16)); tmax = fmaxf(tmax, __shfl_xor(tmax, 32));
    const float mn = fmaxf(m, tmax), alpha = __builtin_amdgcn_exp2f(m - mn);
    m = mn;
    float ps = 0.f;
#pragma unroll
    for (int k4 = 0; k4 < 4; ++k4)
#pragma unroll
        for (int ii = 0; ii < 4; ++ii) ps += (FULL || (vmask & (1u << (k4 * 4 + ii)))) ? __builtin_amdgcn_exp2f(st[k4][ii] - mn) : 0.f;
    lsum = lsum * alpha + ps;
}
DI float wave_max(float v) {
    int x = __float_as_int(v);
    x = __float_as_int(fmaxf(__int_as_float(x), __int_as_float(__builtin_amdgcn_update_dpp(x, x, 0xB1, 0xF, 0xF, false))));
    x = __float_as_int(fmaxf(__int_as_float(x), __int_as_float(__builtin_amdgcn_update_dpp(x, x, 0x4E, 0xF, 0xF, false))));
    x = __float_as_int(fmaxf(__int_as_float(x), __int_as_float(__builtin_amdgcn_update_dpp(x, x, 0x141, 0xF, 0xF, false))));
    x = __float_as_int(fmaxf(__int_as_float(x), __int_as_float(__builtin_amdgcn_update_dpp(x, x, 0x140, 0xF, 0xF, false))));
    const float a = __int_as_float(__builtin_amdgcn_readlane(x, 0)), b = __int_as_float(__builtin_amdgcn_readlane(x, 16));
    const float c = __int_as_float(__builtin_amdgcn_readlane(x, 32)), d = __int_as_float(__builtin_amdgcn_readlane(x, 48));
    return fmaxf(fmaxf(a, b), fmaxf(c, d));
}
DI void nsa_item(const Params& p, int bk, int qb, char* smem, float Mb) {
    const int tid = tid_(), lane = tid & 63, wave = __builtin_amdgcn_readfirstlane(tid >> 6), fr = lane & 15, fq = lane >> 4;
    const int b = bk >> 1, kvh = bk & 1, cur = qb;
    const int t0 = qb * 64 + wave * 16;
    const size_t n0 = (size_t)b * T_ + t0, nb0 = (size_t)b * T_ + qb * 64;
    float* imp = (float*)(smem + wave * 17664);
    int* sel = (int*)(smem + wave * 17664 + 16640);
    unsigned long long* masks = (unsigned long long*)(smem + 70656);
    float* acc = (float*)smem;
    float* accl = acc + 64 * 193;
    const bf16_t* gatep = p.proj + (n0 + fr) * DINP + C_GATE + kvh * 9;
    const int tq = t0 + fr;
    const int nforced = cur >= 2 ? 3 : cur + 1;

    {
        const int nv = tq >= 31 ? ((tq - 31) >> 4) + 1 : 0;
        const int nvmax = t0 >= 16 ? (t0 >> 4) : 0;
        const int ntile = (nvmax + 63) >> 6;
        const bf16_t* KCp = p.kc + (size_t)bk * 1024 * 64;
        const bf16_t* VCp = p.vct + (size_t)bk * 16 * 4096;
        bf16x8 qf[3][2];
#pragma unroll
        for (int g = 0; g < 3; ++g) {
            qf[g][0] = *(const bf16x8*)(p.qn + ((n0 + fr) * 6 + kvh * 3 + g) * 64 + fq * 8);
            qf[g][1] = *(const bf16x8*)(p.qn + ((n0 + fr) * 6 + kvh * 3 + g) * 64 + 32 + fq * 8);
        }
        float m[3], ls[3];
#pragma unroll
        for (int g = 0; g < 3; ++g) { m[g] = -1e30f; ls[g] = 0.f; }
        {
            bf16x8 kn[4][2];
            if (ntile > 0) ldfrag(KCp, fr, fq, kn);
            for (int kt = 0; kt < ntile; ++kt) {
                bf16x8 kf[4][2];
#pragma unroll
                for (int k4 = 0; k4 < 4; ++k4) { kf[k4][0] = kn[k4][0]; kf[k4][1] = kn[k4][1]; }
                ldfrag(KCp + (kt + 1 < ntile ? kt + 1 : kt) * 4096, fr, fq, kn);
                unsigned vm = 0;
#pragma unroll
                for (int k4 = 0; k4 < 4; ++k4)
#pragma unroll
                    for (int ii = 0; ii < 4; ++ii) if (kt * 64 + k4 * 16 + fq * 4 + ii < nv) vm |= 1u << (k4 * 4 + ii);
                const bool full = (kt + 1) * 64 <= nvmax - 1;
                if (full) {
#pragma unroll
                    for (int g = 0; g < 3; ++g) { f32x4 st[4]; st_from(kf, qf[g], st); stats_step<true>(st, vm, m[g], ls[g]); }
                } else {
#pragma unroll
                    for (int g = 0; g < 3; ++g) { f32x4 st[4]; st_from(kf, qf[g], st); stats_step(st, vm, m[g], ls[g]); }
                }
            }
        }
        float inv[3];
#pragma unroll
        for (int g = 0; g < 3; ++g) { float l2 = ls[g]; l2 += __shfl_xor(l2, 16); l2 += __shfl_xor(l2, 32); inv[g] = l2 > 0.f ? 1.f / l2 : 0.f; }
        f32x4 o[3][4];
#pragma unroll
        for (int g = 0; g < 3; ++g)
#pragma unroll
            for (int dt = 0; dt < 4; ++dt) o[g][dt] = (f32x4){0.f, 0.f, 0.f, 0.f};
        float carry = 0.f;
        for (int kt = 0; kt < ntile; ++kt) {
            bf16x8 kf[4][2], vf[4][2];
            ldfrag(KCp + kt * 4096, fr, fq, kf);
            ldfrag(VCp + kt * 4096, fr, fq, vf);
            float s4[4], p3[4];
#pragma unroll
            for (int k4 = 0; k4 < 4; ++k4) { s4[k4] = 0.f; p3[k4] = 0.f; }
#pragma unroll
            for (int g = 0; g < 3; ++g) {
                f32x4 st[4];
                st_from(kf, qf[g], st);
#pragma unroll
                for (int k4 = 0; k4 < 4; ++k4) {
#pragma unroll
                    for (int ii = 0; ii < 4; ++ii) {
                        const float pv = (kt * 64 + k4 * 16 + fq * 4 + ii < nv) ? __builtin_amdgcn_exp2f(st[k4][ii] - m[g]) * inv[g] : 0.f;
                        st[k4][ii] = pv; s4[k4] += pv;
                    }
                    p3[k4] += st[k4][3];
                }
                pv_from(vf, st, o[g]);
            }
            float nb[4];
#pragma unroll
            for (int k4 = 0; k4 < 4; ++k4) nb[k4] = __shfl(p3[k4], (lane + 48) & 63);
#pragma unroll
            for (int k4 = 0; k4 < 4; ++k4) {
                const float add = fq >= 1 ? nb[k4] : (k4 >= 1 ? nb[k4 >= 1 ? k4 - 1 : 0] : carry);
                imp[fr * 260 + kt * 16 + k4 * 4 + fq] = s4[k4] + add;
            }
            carry = nb[3];
        }
#pragma unroll
        for (int g = 0; g < 3; ++g) {
            const float gate = sigmoidf_(bf2f(gatep[g * 3 + 0]));
#pragma unroll
            for (int dt = 0; dt < 4; ++dt) {
                const f32x4 r = o[g][dt] * gate;
                u32x2 o2; o2[0] = pk2(r[0], r[1]); o2[1] = pk2(r[2], r[3]);
                *(u32x2*)(p.hy + (n0 + fr) * DM + 384 + (kvh * 3 + g) * 64 + dt * 16 + fq * 4) = o2;
            }
        }
    }
    __builtin_amdgcn_fence(__ATOMIC_SEQ_CST, "workgroup");

    {
        const int need = 16 - nforced;
        const int ncand = cur >= 2 ? cur - 2 : 0;
#pragma unroll 1
        for (int qi = 0; qi < 16; qi += 4) {
#pragma unroll
            for (int u = 0; u < 4; ++u)
                if (lane < 16) {
                    int v = -1;
                    if (ncand <= need && lane >= nforced && lane - nforced < ncand) v = lane - nforced + 1;
                    sel[(qi + u) * 16 + lane] = v;
                }
            if (ncand > need) {
                float key[4][4];
#pragma unroll
                for (int u = 0; u < 4; ++u)
#pragma unroll
                    for (int r = 0; r < 4; ++r) {
                        const int j = lane + 64 * r;
                        key[u][r] = (j >= 1 && j <= cur - 2) ? imp[(qi + u) * 260 + j] : -1.f;
                    }
                for (int s = 0; s < need; ++s) {
#pragma unroll
                    for (int u = 0; u < 4; ++u) {
                        const float best = wave_max(fmaxf(fmaxf(key[u][0], key[u][1]), fmaxf(key[u][2], key[u][3])));
                        int jstar = 1 << 20;
#pragma unroll
                        for (int r = 3; r >= 0; --r) {
                            const unsigned long long bm = __ballot(key[u][r] == best);
                            if (bm) jstar = 64 * r + (int)__builtin_ctzll(bm);
                        }
#pragma unroll
                        for (int r = 0; r < 4; ++r) if (lane + 64 * r == jstar) key[u][r] = -1.f;
                        if (lane == 0) sel[(qi + u) * 16 + nforced + s] = jstar;
                    }
                }
            }
        }
    }
    __builtin_amdgcn_fence(__ATOMIC_SEQ_CST, "workgroup");
#pragma unroll
    for (int e = lane; e < 256; e += 64) {
        const int jb = sel[e];
        if ((e & 15) >= nforced && jb > 0) atomicOr(&masks[jb], 1ull << (wave * 16 + (e >> 4)));
    }
    __syncthreads();

    const bf16_t* KS = p.ksn + (size_t)bk * T_ * 64;
    const bf16_t* VS = p.vst + (size_t)bk * 256 * 4096;
    {
        char* tb = smem;
        bf16x8 qf[3][2];
#pragma unroll
        for (int g = 0; g < 3; ++g) {
            qf[g][0] = *(const bf16x8*)(p.qn + ((n0 + fr) * 6 + kvh * 3 + g) * 64 + fq * 8);
            qf[g][1] = *(const bf16x8*)(p.qn + ((n0 + fr) * 6 + kvh * 3 + g) * 64 + 32 + fq * 8);
        }
        float ls[3];
        f32x4 o[3][4];
#pragma unroll
        for (int g = 0; g < 3; ++g) {
            ls[g] = 0.f;
#pragma unroll
            for (int dt = 0; dt < 4; ++dt) o[g][dt] = (f32x4){0.f, 0.f, 0.f, 0.f};
        }
        auto next_valid = [&](int j, unsigned long long& mout) {
            for (; j <= cur; ++j) {
                if (j == 0 || j >= cur - 1) { mout = ~0ull; break; }
                const unsigned long long mm = masks[j];
                const unsigned mlo = __builtin_amdgcn_readfirstlane((unsigned)mm), mhi = __builtin_amdgcn_readfirstlane((unsigned)(mm >> 32));
                mout = ((unsigned long long)mhi << 32) | mlo;
                if (mout) break;
            }
            return j;
        };
        u32x4 rg[4];
        const int l_row = (tid >> 3) & 31, l_cc = tid & 7;
        auto gload = [&](int j) {
#pragma unroll
            for (int i = 0; i < 4; ++i) {
                const bf16_t* src = ((i >> 1) ? VS : KS) + (size_t)j * 4096 + (l_row + 32 * (i & 1)) * 64 + l_cc * 8;
                rg[i] = *(const u32x4*)src;
            }
        };
        auto lstore = [&](int bsel) {
#pragma unroll
            for (int i = 0; i < 4; ++i) *(u32x4*)(tb + bsel * 18432 + (i >> 1) * 9216 + (l_row + 32 * (i & 1)) * 144 + l_cc * 16) = rg[i];
        };
        unsigned long long m = 0ull, mn = 0ull;
        int j = next_valid(0, m);
        gload(j); lstore(0);
        __syncthreads();
        int bsel = 0;
        while (j <= cur) {
            const int jn = next_valid(j + 1, mn);
            gload(jn <= cur ? jn : j);
            const unsigned sub = (unsigned)(m >> (wave * 16)) & 0xffffu;
            if (sub) {
                const char* kb_ = tb + bsel * 18432 + fr * 144 + fq * 16;
                bf16x8 kf[4][2], vf[4][2];
#pragma unroll
                for (int k4 = 0; k4 < 4; ++k4) {
                    kf[k4][0] = *(const bf16x8*)(kb_ + k4 * 16 * 144); kf[k4][1] = *(const bf16x8*)(kb_ + k4 * 16 * 144 + 64);
                    vf[k4][0] = *(const bf16x8*)(kb_ + 9216 + k4 * 16 * 144); vf[k4][1] = *(const bf16x8*)(kb_ + 9216 + k4 * 16 * 144 + 64);
                }
                const bool mine = (sub >> fr) & 1u;
                const float Ml = mine ? Mb : 3.0e38f;
                const bool diag = (j == cur);
#pragma unroll
                for (int g = 0; g < 3; ++g) {
                    f32x4 st[4];
                    st_from(kf, qf[g], st, -Ml);
                    if (diag) {
#pragma unroll
                        for (int k4 = 0; k4 < 4; ++k4)
#pragma unroll
                            for (int ii = 0; ii < 4; ++ii) {
                                const float pv = (j * 64 + k4 * 16 + fq * 4 + ii <= tq) ? __builtin_amdgcn_exp2f(st[k4][ii]) : 0.f;
                                st[k4][ii] = pv; ls[g] += pv;
                            }
                    } else {
#pragma unroll
                        for (int k4 = 0; k4 < 4; ++k4)
#pragma unroll
                            for (int ii = 0; ii < 4; ++ii) { const float pv = __builtin_amdgcn_exp2f(st[k4][ii]); st[k4][ii] = pv; ls[g] += pv; }
                    }
                    pv_from(vf, st, o[g]);
                }
            }
            lstore(bsel ^ 1);
            __syncthreads();
            bsel ^= 1; j = jn; m = mn;
        }
#pragma unroll
        for (int g = 0; g < 3; ++g) {
            float l2 = ls[g]; l2 += __shfl_xor(l2, 16); l2 += __shfl_xor(l2, 32);
            float* ar = acc + (wave * 16 + fr) * 193 + g * 64 + fq * 4;
#pragma unroll
            for (int dt = 0; dt < 4; ++dt)
#pragma unroll
                for (int ii = 0; ii < 4; ++ii) ar[dt * 16 + ii] = o[g][dt][ii];
            if (fq == 0) accl[(wave * 16 + fr) * 3 + g] = l2;
        }
    }
    __syncthreads();
    masks[tid] = 0ull;

    {
        const bf16_t* KW = p.kwn + (size_t)bk * T_ * 64;
        const bf16_t* VW = p.vwt + (size_t)bk * 256 * 4096;
        const int lo = t0 - 511 > 0 ? t0 - 511 : 0;
        const int kb0 = lo >> 6, kb1 = t0 >> 6;
        bf16x8 qf[3][2];
#pragma unroll
        for (int g = 0; g < 3; ++g) {
            qf[g][0] = *(const bf16x8*)(p.qn + ((n0 + fr) * 6 + kvh * 3 + g) * 64 + fq * 8);
            qf[g][1] = *(const bf16x8*)(p.qn + ((n0 + fr) * 6 + kvh * 3 + g) * 64 + 32 + fq * 8);
        }
        float m[3], ls[3];
        f32x4 o[3][4];
#pragma unroll
        for (int g = 0; g < 3; ++g) {
            m[g] = -1e30f; ls[g] = 0.f;
#pragma unroll
            for (int dt = 0; dt < 4; ++dt) o[g][dt] = (f32x4){0.f, 0.f, 0.f, 0.f};
        }
        for (int kb = kb0; kb <= kb1; ++kb) {
            bf16x8 kf[4][2], vf[4][2];
            ldfrag(KW + (size_t)kb * 4096, fr, fq, kf);
            ldfrag(VW + (size_t)kb * 4096, fr, fq, vf);
            unsigned vm = 0;
#pragma unroll
            for (int k4 = 0; k4 < 4; ++k4)
#pragma unroll
                for (int ii = 0; ii < 4; ++ii) { const int kp = kb * 64 + k4 * 16 + fq * 4 + ii; if (kp <= tq && kp > tq - 512) vm |= 1u << (k4 * 4 + ii); }
            const bool full = (kb * 64 + 63 <= t0) && (kb * 64 > t0 + 15 - 512);
            if (full) {
#pragma unroll
                for (int g = 0; g < 3; ++g) { f32x4 st[4]; st_from(kf, qf[g], st); online_step<true>(st, vm, m[g], ls[g], o[g]); pv_from(vf, st, o[g]); }
            } else {
#pragma unroll
                for (int g = 0; g < 3; ++g) { f32x4 st[4]; st_from(kf, qf[g], st); online_step(st, vm, m[g], ls[g], o[g]); pv_from(vf, st, o[g]); }
            }
        }
#pragma unroll
        for (int g = 0; g < 3; ++g) {
            const int h = kvh * 3 + g;
            float lsum = ls[g];
            lsum += __shfl_xor(lsum, 16); lsum += __shfl_xor(lsum, 32);
            const float inv = lsum > 0.f ? 1.f / lsum : 0.f;
            const float gate2 = sigmoidf_(bf2f(gatep[g * 3 + 2])) * inv;
            const float sl = accl[(wave * 16 + fr) * 3 + g];
            const float gate1 = sigmoidf_(bf2f(gatep[g * 3 + 1])) * (sl > 0.f ? 1.f / sl : 0.f);
            const float* ar = acc + (wave * 16 + fr) * 193 + g * 64 + fq * 4;
#pragma unroll
            for (int dt = 0; dt < 4; ++dt) {
                bf16_t* yp = p.hy + (n0 + fr) * DM + 384 + h * 64 + dt * 16 + fq * 4;
                const u32x2 pc = *(const u32x2*)yp;
                f32x4 r = o[g][dt] * gate2;
                r[0] += ar[dt * 16 + 0] * gate1 + __uint_as_float(pc[0] << 16); r[1] += ar[dt * 16 + 1] * gate1 + __uint_as_float(pc[0] & 0xffff0000u);
                r[2] += ar[dt * 16 + 2] * gate1 + __uint_as_float(pc[1] << 16); r[3] += ar[dt * 16 + 3] * gate1 + __uint_as_float(pc[1] & 0xffff0000u);
                u32x2 o2; o2[0] = pk2(r[0], r[1]); o2[1] = pk2(r[2], r[3]);
                *(u32x2*)yp = o2;
            }
        }
    }
    __syncthreads();
}

DI void phase_nsa(const Params& p, int l, int first, char* smem) {
    const int lane = tid_() & 63;
    float gq = fabsf(p.q_norm[l * 64 + lane]), gk = fabsf(p.k_norm[(l * 3 + 1) * 64 + lane]);
#pragma unroll
    for (int o = 32; o >= 1; o >>= 1) { gq = fmaxf(gq, __shfl_xor(gq, o)); gk = fmaxf(gk, __shfl_xor(gk, o)); }
    const float Mb = (8.f * gq * gk * 1.02f + 0.05f) * 1.44269504089f;
    const int bk = ((int)blockIdx.x & 7) >> 1;
    ((unsigned long long*)(smem + 70656))[tid_()] = 0ull;
    volatile int* slot = (volatile int*)(smem + 72704);
    __syncthreads();
    for (;;) {
        if (tid_() == 0) *slot = atomicAdd(p.nsa_ctr + l * 4 + bk, 1);
        __syncthreads();
        const int i = *slot;
        if (i >= 256) break;
        nsa_item(p, bk, 255 - i, smem, Mb);
    }
}

#define XB_TMO      128
#define XB_XCNT(j)  (256  + 64 * (j))
#define XB_XSUB(j)  (1280 + 64 * (j))
#define XB_XGEN(j)  (2304 + 64 * (j))
#define XB_TOP      3328
#define XB_TOPGEN   3392
#define XCD_BAR_WORDS 3456
#define XB_SPIN_CAP (1u << 18)
#define LAS __attribute__((address_space(3)))
DI unsigned xb_ld(unsigned* p)              { return __hip_atomic_load(p, __ATOMIC_RELAXED, __HIP_MEMORY_SCOPE_AGENT); }
DI unsigned xb_add(unsigned* p, unsigned v) { return __hip_atomic_fetch_add(p, v, __ATOMIC_RELAXED, __HIP_MEMORY_SCOPE_AGENT); }
DI unsigned xb_xcc_id() { return (unsigned)__builtin_amdgcn_s_getreg((3 << 11) | 20) & 0xFu; }
#define XB_SPIN(cond, bar) do { unsigned _sp = 0; while (cond) { __builtin_amdgcn_s_sleep(1); \
    if ((++_sp & 255u) == 0u) { if (xb_ld(&(bar)[XB_TMO])) break; if (_sp > XB_SPIN_CAP) { atomicAdd(&(bar)[XB_TMO], 1u); break; } } } } while (0)
struct XcdBarrier { unsigned* bar; unsigned x; volatile LAS unsigned* st; };
DI XcdBarrier xcd_barrier_post(unsigned* bar, volatile LAS unsigned* st) {
    XcdBarrier b; b.bar = bar; b.x = xb_xcc_id(); b.st = st;
    if (threadIdx.x == 0) (void)xb_add(&bar[XB_XCNT(b.x)], 1u);
    return b;
}
DI void xcd_barrier_complete(unsigned* bar, unsigned x, unsigned& nloc, unsigned& nx) {
    const unsigned G = gridDim.x * gridDim.y * gridDim.z;
    unsigned sum, cnt, mine, sp = 0u;
    for (;;) {
        sum = 0u; cnt = 0u; mine = 0u;
#pragma unroll
        for (unsigned j = 0; j < 16; ++j) { const unsigned c = xb_ld(&bar[XB_XCNT(j)]); sum += c; cnt += (c > 0u) ? 1u : 0u; mine = (j == x) ? c : mine; }
        if (sum == G) break;
        __builtin_amdgcn_s_sleep(1);
        if ((++sp & 255u) == 0u) { if (xb_ld(&bar[XB_TMO])) break; if (sp > XB_SPIN_CAP) { atomicAdd(&bar[XB_TMO], 1u); break; } }
    }
    nloc = mine > 0u ? mine : 1u; nx = cnt > 0u ? cnt : 1u;
}
DI void xcd_barrier(const XcdBarrier& b) {
    asm volatile("s_waitcnt vmcnt(0)" ::: "memory");
    __syncthreads();
    if (threadIdx.x == 0) {
        unsigned* bar = b.bar;
        __builtin_amdgcn_s_waitcnt(0);
        unsigned nloc = b.st[0], nx = b.st[1];
        if (nloc == 0u) { xcd_barrier_complete(bar, b.x, nloc, nx); b.st[0] = nloc; b.st[1] = nx; }
        const unsigned old = xb_add(&bar[XB_XSUB(b.x)], 1u);
        const unsigned gen = old / nloc;
        if (old + 1u == (gen + 1u) * nloc) {
            __builtin_amdgcn_fence(__ATOMIC_RELEASE, "agent");
            asm volatile("s_waitcnt vmcnt(0)" ::: "memory");
            const unsigned og = xb_add(&bar[XB_TOP], 1u);
            const unsigned tg = og / nx;
            if (og + 1u == (tg + 1u) * nx) xb_add(&bar[XB_TOPGEN], 1u);
            else XB_SPIN(xb_ld(&bar[XB_TOPGEN]) == tg, bar);
            __builtin_amdgcn_fence(__ATOMIC_ACQUIRE, "agent");
            xb_add(&bar[XB_XGEN(b.x)], 1u);
            asm volatile("s_waitcnt vmcnt(0)" ::: "memory");
        } else {
            XB_SPIN(xb_ld(&bar[XB_XGEN(b.x)]) == gen, bar);
            __builtin_amdgcn_fence(__ATOMIC_ACQUIRE, "agent");
            asm volatile("s_waitcnt vmcnt(0)" ::: "memory");
        }
    }
    __syncthreads();
}

#ifndef PHDUP
#define PHDUP 0
#endif
#ifndef PHMASK
#define PHMASK 0xffff
#endif
DI void run_phase(const Params& p, int ph, int l, char* smem) {
    if (!((PHMASK >> ph) & 1)) return;
    const float* xin = (l == 0) ? p.x : p.out;
    switch (ph) {
    case 0: phase_convert(p, smem); break;
    case 1: phase_rmsnorm(xin, p.norm_mix + l * DM, p.hy); break;
    case 2: gemm_phase<0>(p.hy, p.wb_in + (size_t)l * DINP * DM, NTOK, DINP, DM, p.proj, p.side, nullptr, nullptr, smem,
                          l == 0 ? nullptr : p.ssq + 1 * NTOK); break;
    case 3:
        phase_gdn_prep(p, l, smem);
        phase_nsa_prep(p, l, smem);
        phase_compress(p, l, smem);
        phase_pool(p, l, smem);
        break;
    case 4:
        if (blockIdx.x < NSCAN) { gdn_scan_block(p, blockIdx.x, smem); if (PHDUP & 0x400) gdn_scan_block(p, blockIdx.x, smem); }
        phase_nsa(p, l, NSCAN, smem);
        break;
    case 5: phase_gdn_final(p, l); break;
    case 6: gemm_phase<2>(p.hy, p.wb_out + (size_t)l * DM * DM, NTOK, DM, DM, nullptr, nullptr, xin, p.out, smem,
                          nullptr, p.h2, p.norm_ffn + l * DM, p.ssq + (l == 0 ? 0 : 2) * NTOK); break;
    case 8: gemm_phase<1>(p.h2, p.wb_f1 + (size_t)l * DFF * DM, NTOK, DFF, DM, p.hid, nullptr, nullptr, nullptr, smem,
                          p.ssq + (l == 0 ? 0 : 2) * NTOK); break;
    case 9:
        if (l == 0) gemm_phase<2>(p.hid, p.wb_f2 + (size_t)l * DM * DFF, NTOK, DM, DFF, nullptr, nullptr, p.out, p.out, smem,
                                  nullptr, p.hy, p.norm_mix + DM, p.ssq + 1 * NTOK);
        else gemm_phase<2>(p.hid, p.wb_f2 + (size_t)l * DM * DFF, NTOK, DM, DFF, nullptr, nullptr, p.out, p.out, smem);
        break;
    }
}

#if MEGA
__global__ void __launch_bounds__(256, 2) mega_kernel(Params p) {
    extern __shared__ __attribute__((aligned(16))) char smem[];
    cg::grid_group grid = cg::this_grid();
    volatile LAS unsigned* st = (volatile LAS unsigned*)(smem + LDS_BYTES);
    if (threadIdx.x < 4) st[threadIdx.x] = 0u;
    __syncthreads();
    const XcdBarrier xb = xcd_barrier_post(p.bar, st);
    run_phase(p, 0, 0, smem);
    run_phase(p, 1, 0, smem);
    grid.sync();
#define RUNPH(PH) do { run_phase(p, PH, l, smem); xcd_barrier(xb); if ((PHDUP >> PH) & 1) { run_phase(p, PH, l, smem); xcd_barrier(xb); } } while (0)
#pragma unroll 1
    for (int l = 0; l < 2; ++l) {
        RUNPH(2); RUNPH(3); RUNPH(4); RUNPH(5); RUNPH(6); RUNPH(8);
        run_phase(p, 9, l, smem);
        if (l == 0) xcd_barrier(xb);
    }
}
#endif

extern "C" void kernel_launch(void* const* d_in, const int* in_sizes, int n_in, void* d_out, int out_size, void* d_ws, size_t ws_size,
                              hipStream_t stream) {
    Params p{};
    p.x = (const float*)d_in[0]; p.norm_mix = (const float*)d_in[1]; p.w_in = (const float*)d_in[2]; p.conv_w = (const float*)d_in[3];
    p.a_log = (const float*)d_in[4]; p.dt_bias = (const float*)d_in[5]; p.gdn_norm = (const float*)d_in[6]; p.q_norm = (const float*)d_in[7];
    p.k_norm = (const float*)d_in[8]; p.cmp_pos = (const float*)d_in[9]; p.cmp_w1 = (const float*)d_in[10]; p.cmp_w2 = (const float*)d_in[11];
    p.pool_w = (const float*)d_in[12]; p.pool_scale = (const float*)d_in[13]; p.w_out = (const float*)d_in[14]; p.norm_ffn = (const float*)d_in[15];
    p.w_ffn1 = (const float*)d_in[16]; p.w_ffn2 = (const float*)d_in[17];
    p.out = (float*)d_out;
    char* ws = (char*)d_ws; size_t off = 0;
    auto take = [&](size_t bytes) { char* r = ws + off; off += (bytes + 255) & ~(size_t)255; return r; };
    p.wb_in = (bf16_t*)take((size_t)2 * DINP * DM * 2);
    p.wb_out = (bf16_t*)take((size_t)2 * DM * DM * 2);
    p.wb_f1 = (bf16_t*)take((size_t)2 * DFF * DM * 2);
    p.wb_f2 = (bf16_t*)take((size_t)2 * DFF * DM * 2);
    p.wb_c1 = (bf16_t*)take((size_t)4 * 256 * 2048 * 2);
    p.wb_c2 = (bf16_t*)take((size_t)4 * 64 * 256 * 2);
    p.hy = (bf16_t*)take((size_t)NTOK * DM * 2);
    p.proj = (bf16_t*)take((size_t)NTOK * DINP * 2);
    p.hid = p.proj;
    p.rec = take((size_t)3072 * REC);
    p.glast = (float*)take(3072 * 4);
    p.side = (float*)take((size_t)NTOK * 12 * 4);
    p.qn = (bf16_t*)take((size_t)NTOK * 384 * 2);
    p.ksn = (bf16_t*)take((size_t)NTOK * 128 * 2);
    p.kwn = (bf16_t*)take((size_t)NTOK * 128 * 2);
    p.vst = (bf16_t*)take((size_t)NTOK * 128 * 2);
    p.vwt = (bf16_t*)take((size_t)NTOK * 128 * 2);
    p.kc = (bf16_t*)take((size_t)4 * 1024 * 64 * 2);
    p.vct = (bf16_t*)take((size_t)4 * 16 * 4096 * 2);
    p.bar = (unsigned*)take((size_t)XCD_BAR_WORDS * 4);
    p.ssq = (float*)take((size_t)3 * NTOK * 4);
    p.nsa_ctr = (int*)take(256);
    p.h2 = (bf16_t*)((char*)p.proj + (size_t)NTOK * DFF * 2);
    if ((char*)p.h2 + (size_t)NTOK * DM * 2 > (char*)p.kc) { fprintf(stderr, "h2 overlay does not fit\n"); return; }
    if (off > ws_size) { fprintf(stderr, "workspace too small: need %zu have %zu\n", off, ws_size); return; }
#if MEGA
    constexpr int kDynLds = LDS_BYTES + 64;
    hipMemsetAsync(p.bar, 0, (size_t)XCD_BAR_WORDS * 4, stream);
    hipFuncSetAttribute((const void*)mega_kernel, hipFuncAttributeMaxDynamicSharedMemorySize, kDynLds);
    int dev = 0, cus = 0, per_cu = 0;
    hipGetDevice(&dev);
    hipDeviceGetAttribute(&cus, hipDeviceAttributeMultiprocessorCount, dev);
    hipOccupancyMaxActiveBlocksPerMultiprocessor(&per_cu, mega_kernel, 256, kDynLds);
    if (per_cu > 2) per_cu = 2;
    int grid = cus * per_cu;
    void* args[] = {&p};
    hipError_t e = hipLaunchCooperativeKernel((void*)mega_kernel, dim3(grid), dim3(256), args, kDynLds, stream);
    if (e != hipSuccess) fprintf(stderr, "cooperative launch failed: %s (grid %d)\n", hipGetErrorString(e), grid);
#endif
}
```
